# Optimizing an MI355X kernel written in HIP

```python
import jax, jax.numpy as jnp
from jax import lax
import numpy as np

D_MODEL = 2048
BATCH = 16
SEQ = 256
DEPTH = 4
DEC_BATCH = 2
DEC_SEQ = 1024
PAST_LEN = 256

GRID_W = 64
N_MIXERS = 2
NA_HEADS = 16
NA_HEAD_DIM = D_MODEL // NA_HEADS
NA_WIN_ROWS = 8
NA_WIN_COLS = 16
GLA_HEADS = 4
GLA_KEY_DIM = D_MODEL // 2
GLA_VAL_DIM = D_MODEL
GLA_DK = GLA_KEY_DIM // GLA_HEADS
GLA_DV = GLA_VAL_DIM // GLA_HEADS
GLA_GATE_RANK = 16
GLA_GATE_NORM = 16.0
GLA_CHUNK = 64
D_FF = 4 * D_MODEL
ROPE_THETA = 10000.0
EPS = 1e-6
ATTN_Q_BLOCK = 128
N_NA_LAYERS = (DEPTH + 1) // 2
N_GLA_LAYERS = DEPTH // 2
NEG_INF = -1e30

kernel_name = 'hybrid_natten_gla_diffusion_step'


def rmsnorm(x, g):
    xf = x.astype(jnp.float32)
    y = xf * lax.rsqrt(jnp.mean(xf * xf, axis=-1, keepdims=True) + EPS)
    return (y * g.astype(jnp.float32)).astype(x.dtype)


def adaln(cond, w, b):
    m = jax.nn.silu(cond) @ w + b
    m = m.reshape(cond.shape[0], 6, 1, D_MODEL)
    return [m[:, j] for j in range(6)]


def modulate(x, g, shift, scale):
    return rmsnorm(x, g) * (1 + scale) + shift


def split_heads(x, h):
    b, l, _ = x.shape
    return x.reshape(b, l, h, -1).transpose(0, 2, 1, 3)


def merge_heads(x):
    b, h, l, d = x.shape
    return x.transpose(0, 2, 1, 3).reshape(b, l, h * d)


def na_qkv(h, w_qkv):
    b, l, _ = h.shape
    p = (h @ w_qkv).reshape(b, l, 3, NA_HEADS, NA_HEAD_DIM).transpose(2, 0, 3, 1, 4)
    return p[0], p[1], p[2]


def context_attention(q, k, v):
    b, h, l, dh = q.shape
    nb = l // ATTN_Q_BLOCK
    qb = q.reshape(b, h, nb, ATTN_Q_BLOCK, dh).transpose(2, 0, 1, 3, 4)

    def one(qblk):
        s = jnp.einsum('bhqd,bhkd->bhqk', qblk, k).astype(jnp.float32) * (dh ** -0.5)
        p = jax.nn.softmax(s, axis=-1).astype(v.dtype)
        return jnp.einsum('bhqk,bhkd->bhqd', p, v)

    o = lax.map(one, qb)
    return o.transpose(1, 2, 0, 3, 4).reshape(b, h, l, dh)


def neighborhood_attention(q, k, v, k_ctx, v_ctx, rpb):
    b, h, t, dh = q.shape
    rows = t // GRID_W
    kr = min(NA_WIN_ROWS, rows)
    kw = NA_WIN_COLS
    scale = dh ** -0.5
    qg = q.reshape(b, h, rows, GRID_W, dh)
    kg = k.reshape(b, h, rows, GRID_W, dh)
    vg = v.reshape(b, h, rows, GRID_W, dh)
    r = jnp.arange(rows)
    c = jnp.arange(GRID_W)
    row_start = jnp.clip(r - kr // 2, 0, rows - kr)
    row_idx = row_start[:, None] + jnp.arange(kr)[None, :]
    col_start = jnp.clip(c - kw // 2, 0, GRID_W - kw)
    col_in = (c[None, :] >= col_start[:, None]) & (c[None, :] < col_start[:, None] + kw)
    k_band = kg[:, :, row_idx]
    v_band = vg[:, :, row_idx]
    s_lat = jnp.einsum('bhrqd,bhrkwd->bhrqkw', qg, k_band).astype(jnp.float32) * scale
    dr = row_idx - r[:, None] + NA_WIN_ROWS - 1
    dc = jnp.clip(c[None, :] - c[:, None] + kw - 1, 0, 2 * kw - 2)
    bias = rpb[:, dr[:, None, :, None], dc[None, :, None, :]]
    s_lat = jnp.where(col_in[None, None, None, :, None, :],
                      s_lat + bias.astype(jnp.float32)[None], NEG_INF)
    s_ctx = jnp.einsum('bhrqd,bhld->bhrql', qg, k_ctx).astype(jnp.float32) * scale
    n_lat = kr * GRID_W
    s = jnp.concatenate([s_lat.reshape(b, h, rows, GRID_W, n_lat), s_ctx], axis=-1)
    p = jax.nn.softmax(s, axis=-1).astype(v.dtype)
    p_lat = p[..., :n_lat].reshape(b, h, rows, GRID_W, kr, GRID_W)
    p_ctx = p[..., n_lat:]
    o = (jnp.einsum('bhrqkw,bhrkwd->bhrqd', p_lat, v_band)
         + jnp.einsum('bhrql,bhld->bhrqd', p_ctx, v_ctx))
    return o.reshape(b, h, t, dh)


def rope_axial(x):
    t_len, d = x.shape[2], x.shape[3]
    t = jnp.arange(t_len)
    half = d // 2
    n = half // 2
    freqs = ROPE_THETA ** (-jnp.arange(n, dtype=jnp.float32) / n)

    def rot(xa, pos):
        ang = pos.astype(jnp.float32)[:, None] * freqs[None, :]
        cos, sin = jnp.cos(ang), jnp.sin(ang)
        x1, x2 = xa[..., :n], xa[..., n:]
        return jnp.concatenate([x1 * cos - x2 * sin, x1 * sin + x2 * cos], axis=-1)

    return jnp.concatenate([rot(x[..., :half], t // GRID_W), rot(x[..., half:], t % GRID_W)], axis=-1)


def gla_chunked(q, k, v, log_a, s0):
    b, h, l, dk = q.shape
    dv = v.shape[-1]
    n = l // GLA_CHUNK
    rs = lambda z: z.reshape(b, h, n, GLA_CHUNK, z.shape[-1])
    q, k, v, log_a = rs(q), rs(k), rs(v), rs(log_a)
    cum = jnp.cumsum(log_a, axis=3)
    cum_last = cum[:, :, :, -1:]
    q_dec = q * jnp.exp(cum)
    k_dec = k * jnp.exp(-cum)
    mask = jnp.tril(jnp.ones((GLA_CHUNK, GLA_CHUNK), dtype=bool))
    attn = jnp.where(mask, jnp.einsum('bhncd,bhnsd->bhncs', q_dec, k_dec), 0.0)
    o_intra = jnp.einsum('bhncs,bhnsv->bhncv', attn, v)
    kv = jnp.einsum('bhncd,bhncv->bhndv', k * jnp.exp(cum_last - cum), v)
    decay = jnp.exp(cum_last[:, :, :, 0])

    def step(s, inp):
        dec, kvn = inp
        return dec[..., None] * s + kvn, s

    s_final, s_prev = lax.scan(step, s0, (jnp.moveaxis(decay, 2, 0), jnp.moveaxis(kv, 2, 0)))
    s_prev = jnp.moveaxis(s_prev, 0, 2)
    o = o_intra + jnp.einsum('bhncd,bhndv->bhncv', q_dec, s_prev)
    return o.reshape(b, h, l, dv), s_final


def gla_mix(h, w_qkvg, w_a1, w_a2, b_a, g_head, w_o, s_init, latent):
    f32 = jnp.float32
    proj = h @ w_qkvg
    q, k, v, g = jnp.split(proj, [GLA_KEY_DIM, 2 * GLA_KEY_DIM, 2 * GLA_KEY_DIM + GLA_VAL_DIM], axis=-1)
    q = split_heads(q, GLA_HEADS).astype(f32)
    k = split_heads(k, GLA_HEADS).astype(f32)
    v = split_heads(v, GLA_HEADS).astype(f32)
    if latent:
        q = rope_axial(q)
        k = rope_axial(k)
    q = q * (GLA_DK ** -0.5)
    flip = lambda z: jnp.flip(z, axis=2)
    outs, finals = [], []
    for d in range(2):
        z = (h @ w_a1[d]) @ w_a2[d] + b_a[d]
        log_a = split_heads(jax.nn.log_sigmoid(z.astype(f32)) / GLA_GATE_NORM, GLA_HEADS)
        s0 = s_init[:, d].astype(f32)
        if d == 0:
            o, sf = gla_chunked(q, k, v, log_a, s0)
        else:
            o, sf = gla_chunked(flip(q), flip(k), flip(v), flip(log_a), s0)
            o = flip(o)
        outs.append(o)
        finals.append(sf)
    o = outs[0] + outs[1]
    o = o * lax.rsqrt(jnp.mean(o * o, axis=-1, keepdims=True) + EPS) * g_head.astype(f32)
    o = o * jax.nn.silu(split_heads(g, GLA_HEADS).astype(f32))
    out = merge_heads(o).astype(h.dtype) @ w_o
    return out, jnp.stack(finals, axis=1).astype(h.dtype)


def sq_relu_mlp(h, w1, w2):
    return jnp.square(jax.nn.relu(h @ w1)) @ w2


def setup_inputs(seed: int = 0) -> dict:
    key = jax.random.key(seed)
    ks = jax.random.split(key, 24)
    nrm = lambda k, shape, s: jax.random.normal(k, shape, jnp.float32) * s
    d = D_MODEL
    return {
        'x_prompt': nrm(ks[0], (BATCH, SEQ, d), 1.0),
        'x_sample': nrm(ks[1], (DEC_BATCH, DEC_SEQ, d), 1.0),
        'cache_na_k': nrm(ks[2], (DEC_BATCH, N_NA_LAYERS, NA_HEADS, PAST_LEN, NA_HEAD_DIM), 1.0),
        'cache_na_v': nrm(ks[3], (DEC_BATCH, N_NA_LAYERS, NA_HEADS, PAST_LEN, NA_HEAD_DIM), 1.0),
        'state_gla': nrm(ks[4], (DEC_BATCH, N_GLA_LAYERS, 2, GLA_HEADS, GLA_DK, GLA_DV), 1.0),
        'c': nrm(ks[5], (DEC_BATCH, d), 1.0),
        'c_ctx': nrm(ks[6], (d,), 1.0),
        'w_ada': nrm(ks[7], (DEPTH, d, 6 * d), 0.5 * d ** -0.5),
        'b_ada': nrm(ks[8], (DEPTH, 6 * d), 0.01),
        'norm_g': 1.0 + nrm(ks[9], (DEPTH, 4, d), 0.01),
        'w_qkv_na': nrm(ks[10], (N_NA_LAYERS, d, 3 * d), d ** -0.5),
        'w_o_na': nrm(ks[11], (N_NA_LAYERS, d, d), d ** -0.5),
        'rpb_na': nrm(ks[12], (N_NA_LAYERS, NA_HEADS, 2 * NA_WIN_ROWS - 1, 2 * NA_WIN_COLS - 1), 0.1),
        'w_qkvg_gla': nrm(ks[13], (N_GLA_LAYERS, d, 2 * GLA_KEY_DIM + 2 * GLA_VAL_DIM), d ** -0.5),
        'w_a1_gla': nrm(ks[14], (N_GLA_LAYERS, 2, d, GLA_GATE_RANK), d ** -0.5),
        'w_a2_gla': nrm(ks[15], (N_GLA_LAYERS, 2, GLA_GATE_RANK, GLA_KEY_DIM), GLA_GATE_RANK ** -0.5),
        'b_a_gla': nrm(ks[16], (N_GLA_LAYERS, 2, GLA_KEY_DIM), 0.1),
        'g_head_gla': 1.0 + nrm(ks[17], (N_GLA_LAYERS, GLA_DV), 0.01),
        'w_o_gla': nrm(ks[18], (N_GLA_LAYERS, GLA_VAL_DIM, d), GLA_VAL_DIM ** -0.5),
        'w1_mlp': nrm(ks[19], (DEPTH, d, D_FF), d ** -0.5),
        'w2_mlp': nrm(ks[20], (DEPTH, D_FF, d), D_FF ** -0.5),
    }


def reference(x_prompt, x_sample, cache_na_k, cache_na_v, state_gla, c, c_ctx,
              w_ada, b_ada, norm_g, w_qkv_na, w_o_na, rpb_na,
              w_qkvg_gla, w_a1_gla, w_a2_gla, b_a_gla, g_head_gla, w_o_gla,
              w1_mlp, w2_mlp):
    xp, xs = x_prompt, x_sample
    new_k, new_v, new_s = [], [], []
    for l in range(DEPTH):
        i = l // N_MIXERS
        sh1p, sc1p, g1p, sh2p, sc2p, g2p = adaln(c_ctx[None], w_ada[l], b_ada[l])
        sh1s, sc1s, g1s, sh2s, sc2s, g2s = adaln(c, w_ada[l], b_ada[l])
        hp = modulate(xp, norm_g[l, 0], sh1p, sc1p)
        hs = modulate(xs, norm_g[l, 0], sh1s, sc1s)
        if l % N_MIXERS == 0:
            qp, kp, vp = na_qkv(hp, w_qkv_na[i])
            yp = merge_heads(context_attention(qp, kp, vp)) @ w_o_na[i]
            new_k.append(kp)
            new_v.append(vp)
            qs, ks_, vs = na_qkv(hs, w_qkv_na[i])
            os_ = neighborhood_attention(qs, ks_, vs, cache_na_k[:, i], cache_na_v[:, i], rpb_na[i])
            ys = merge_heads(os_) @ w_o_na[i]
        else:
            zero_state = jnp.zeros((xp.shape[0], 2, GLA_HEADS, GLA_DK, GLA_DV), jnp.float32)
            yp, sp = gla_mix(hp, w_qkvg_gla[i], w_a1_gla[i], w_a2_gla[i], b_a_gla[i],
                             g_head_gla[i], w_o_gla[i], zero_state, False)
            new_s.append(sp)
            ys, _ = gla_mix(hs, w_qkvg_gla[i], w_a1_gla[i], w_a2_gla[i], b_a_gla[i],
                            g_head_gla[i], w_o_gla[i], state_gla[:, i], True)
        xp = xp + g1p * rmsnorm(yp, norm_g[l, 1])
        xs = xs + g1s * rmsnorm(ys, norm_g[l, 1])
        mp = sq_relu_mlp(modulate(xp, norm_g[l, 2], sh2p, sc2p), w1_mlp[l], w2_mlp[l])
        ms = sq_relu_mlp(modulate(xs, norm_g[l, 2], sh2s, sc2s), w1_mlp[l], w2_mlp[l])
        xp = xp + g2p * rmsnorm(mp, norm_g[l, 3])
        xs = xs + g2s * rmsnorm(ms, norm_g[l, 3])
    new_na_k = jnp.stack(new_k, axis=1)
    new_na_v = jnp.stack(new_v, axis=1)
    new_gla = jnp.stack(new_s, axis=1)
    return (xp, xs, new_na_k, new_na_v, new_gla)
```

```cpp
#include <hip/hip_runtime.h>
#include <cstdio>
#include <cstdint>

#ifndef CFG_NAIVE_GEMM
#define CFG_NAIVE_GEMM 0
#endif
#ifndef CFG_NAIVE_ATTN
#define CFG_NAIVE_ATTN 0
#endif
#ifndef CFG_NAIVE_GLA
#define CFG_NAIVE_GLA 0
#endif
#ifndef Y_BF16
#define Y_BF16 1
#endif
#ifndef OG_BF16
#define OG_BF16 1
#endif
#ifndef CFG_ONE_LAUNCH
#define CFG_ONE_LAUNCH 1
#endif

#define GAS __attribute__((address_space(1)))
#define LAS __attribute__((address_space(3)))
typedef unsigned short bf16;
typedef float f32x4 __attribute__((ext_vector_type(4)));
typedef float f32x2 __attribute__((ext_vector_type(2)));
typedef short bf16x8 __attribute__((ext_vector_type(8)));
typedef short bf16x4 __attribute__((ext_vector_type(4)));
typedef unsigned u32x4 __attribute__((ext_vector_type(4)));
typedef unsigned u32x2 __attribute__((ext_vector_type(2)));

constexpr int D = 2048, T_P = 4096, T_S = 2048, T = 6144, FF = 8192, NL = 4;
constexpr int NMIX = 6400;
constexpr int NQK_NA = 4096, NQK_GLA = 4352;
constexpr float EPS = 1e-6f;
constexpr float LOG2E = 1.4426950408889634f;

constexpr size_t MiB = 1u << 20;
constexpr size_t WS_CTL = 0, CTL_ZERO_BYTES = 1 * MiB;
constexpr size_t WS_MOD = 1 * MiB;
constexpr size_t WS_WMIX = 2 * MiB;
constexpr size_t WS_WO = 102 * MiB;
constexpr size_t WS_W1 = 134 * MiB;
constexpr size_t WS_W2 = 262 * MiB;
constexpr size_t WS_CK = 390 * MiB;
constexpr size_t WS_CVT = 394 * MiB;
constexpr size_t WS_H = 398 * MiB;
constexpr size_t WS_QK = 422 * MiB;
constexpr int VTP = T + 64;
constexpr size_t WS_VT = 470 * MiB;
constexpr size_t WS_TLR = 496 * MiB;
constexpr size_t WS_AO = 497 * MiB;
constexpr size_t WS_OG = 521 * MiB;
constexpr size_t WS_Y = 617 * MiB;
constexpr size_t WS_HID = 713 * MiB;
constexpr size_t WS_END = 809 * MiB;
constexpr int CW_BAR = 4096;

constexpr size_t OUT_X = 0;
constexpr size_t OUT_NK = 12582912, OUT_NV = 29360128, OUT_GLA = 46137344, OUT_TOTAL = 79691776;

__device__ __forceinline__ unsigned f2bf(float f) { unsigned u = __builtin_bit_cast(unsigned, f); return (u + 0x7fffu + ((u >> 16) & 1u)) >> 16; }
__device__ __forceinline__ unsigned pk2(float lo, float hi) { return f2bf(lo) | (f2bf(hi) << 16); }
__device__ __forceinline__ float bf2f(unsigned short b) { return __builtin_bit_cast(float, ((unsigned)b) << 16); }
__device__ __forceinline__ float bflo(unsigned w) { return __builtin_bit_cast(float, w << 16); }
__device__ __forceinline__ float bfhi(unsigned w) { return __builtin_bit_cast(float, w & 0xffff0000u); }
#define LDS_WAIT() asm volatile("s_waitcnt lgkmcnt(0)" ::: "memory")
#define VM_WAIT() asm volatile("s_waitcnt vmcnt(0)" ::: "memory")

namespace pg8 {
#define PG8_LAS __attribute__((address_space(3)))
typedef unsigned short bf16_t;
typedef short bf16x8 __attribute__((ext_vector_type(8)));
typedef float f32x4 __attribute__((ext_vector_type(4)));
typedef unsigned u32x4 __attribute__((ext_vector_type(4)));
constexpr int BM = 256, BK = 64, HALF = 128, HTB = HALF * BK * 2  , STAGE_BYTES = 8 * HTB, NXCD = 8, WGM = 8;

__host__ __device__ __forceinline__ int lds_byte(int r, int c) { const int st = (r >> 4) * 2 + (c >> 5), rr = r & 15, cc = c & 31, ob = rr * 64 + cc * 2; return st * 1024 + (ob ^ (((ob >> 9) & 1) << 5)); }
__host__ __device__ __forceinline__ void stage_rc(int b, int& R, int& C) { const int st = b / 1024, sb = b % 1024, swz = sb ^ (((sb >> 9) & 1) << 5); R = (st >> 1) * 16 + swz / 64; C = (st & 1) * 32 + (swz % 64) / 2; }
__host__ __device__ __forceinline__ int perm32(int rho) { const int n = rho >> 4, i = rho & 15; return 8 * (i >> 2) + 4 * n + (i & 3); }

struct Unit { int pm, pn, k0, nt, part; };
struct Gemm { const bf16_t* A; const bf16_t* Bt; int M, N, K; };

struct StaticOrder {
    int nM, nN, nwg, G, c;
    __host__ __device__ void init(int M, int N, int G_, int c_) { nM = M / BM; nN = N / BM; nwg = nM * nN; G = G_; c = c_; }
    __host__ __device__ bool next(int i, Unit& u) const {
        const long L = (long)i * G + c; if (L >= nwg) return false;
        int wgid = (int)L; { const int q = nwg / NXCD, r = nwg % NXCD, xcd = wgid % NXCD, off = wgid / NXCD; wgid = (xcd < r ? xcd * (q + 1) : r * (q + 1) + (xcd - r) * q) + off; }
        const int nig = WGM * nN, gid = wgid / nig, fm = gid * WGM, gsz = (nM - fm) < WGM ? (nM - fm) : WGM;
        u.pm = fm + ((wgid % nig) % gsz); u.pn = (wgid % nig) / gsz; u.k0 = 0; u.nt = 0; u.part = 0; return true;
    }
    __device__ __forceinline__ void a_ready(const Unit&) const {}
    __device__ __forceinline__ void done(const Unit&) const {}
};

__device__ __forceinline__ unsigned cvt_pk_bf16(float lo, float hi) { unsigned r; asm volatile("v_cvt_pk_bf16_f32 %0, %1, %2" : "=v"(r) : "v"(lo), "v"(hi)); return r; }

template <class Epi, class Sched, bool ALIGN_EPI = false, bool SP2 = false>
__device__ __forceinline__ void gemm_phase(PG8_LAS unsigned char* lds, const Gemm g, const Sched& S, const Epi& E) {
    int tid_l = threadIdx.x; asm volatile("" : "+v"(tid_l)); const int tid = tid_l, wid = __builtin_amdgcn_readfirstlane(tid >> 6), lane = tid & 63, wr = wid >> 2, wc = wid & 3, fr = lane & 15, fq = lane >> 4;
    const int K = g.K;
    unsigned voffA[2], voffB[2];
#pragma unroll
    for (int i = 0; i < 2; ++i) { int R, C; stage_rc(tid * 16 + i * 8192, R, C); const int Rb = Epi::PERM ? ((R & ~31) + perm32(R & 31)) : R;
        voffA[i] = (unsigned)(R * K + C) * 2u; voffB[i] = (unsigned)(Rb * K + C) * 2u; }
    const size_t kstep = (size_t)(BK * 2);
    const size_t hstep = (size_t)HALF * K * 2;
    const size_t tstep = 2 * hstep;
    const unsigned ldsw = (unsigned)wid * 1024u;
    const int aoff = lds_byte(wr * 64 + fr, fq * 8), boff = lds_byte(wc * 32 + fr, fq * 8);
#define PG8_SA(b, h) (((b) * 2 + (h)) * HTB)
#define PG8_SB(b, h) ((4 + (b) * 2 + (h)) * HTB)
#define PG8_STAGE(bufoff, gbase, voff) do { _Pragma("unroll") for (int _i = 0; _i < 2; ++_i) \
        __builtin_amdgcn_global_load_lds((const unsigned*)((const char*)(gbase) + (voff)[_i]), (PG8_LAS unsigned*)(lds + (bufoff) + ldsw + _i * 8192), 16, 0, 0); } while (0)
#define PG8_LDA(dst, b, h) do { _Pragma("unroll") for (int m = 0; m < 4; ++m) _Pragma("unroll") for (int k = 0; k < 2; ++k) dst[m][k] = *(const PG8_LAS bf16x8*)(lds + PG8_SA(b, h) + aoff + m * 2048 + k * 1024); } while (0)
#define PG8_LDB(dst, b, h) do { _Pragma("unroll") for (int n = 0; n < 2; ++n) _Pragma("unroll") for (int k = 0; k < 2; ++k) dst[n][k] = *(const PG8_LAS bf16x8*)(lds + PG8_SB(b, h) + boff + n * 2048 + k * 1024); } while (0)
#define PG8_MMA(ai, bj, At, Bt) do { __builtin_amdgcn_s_setprio(1); _Pragma("unroll") for (int m = 0; m < 4; ++m) _Pragma("unroll") for (int n = 0; n < 2; ++n) _Pragma("unroll") for (int k = 0; k < 2; ++k) \
        acc[ai][bj][m][n] = __builtin_amdgcn_mfma_f32_16x16x32_bf16(Bt[n][k], At[m][k], acc[ai][bj][m][n], 0, 0, 0); __builtin_amdgcn_s_setprio(0); } while (0)
#define PG8_WAIT_V(n) asm volatile("s_waitcnt vmcnt(" #n ")" ::: "memory")
#define PG8_WAIT_L(n) asm volatile("s_waitcnt lgkmcnt(" #n ")" ::: "memory")
#define PG8_BAR __builtin_amdgcn_s_barrier()
#define PG8_SCHED __builtin_amdgcn_sched_barrier(0)
    Unit cur, nxt; int ui = 0;
    if (!S.next(0, cur)) return;
    f32x4 acc[2][2][4][2];
#pragma unroll
    for (int a = 0; a < 2; ++a)
#pragma unroll
        for (int b = 0; b < 2; ++b)
#pragma unroll
            for (int m = 0; m < 4; ++m)
#pragma unroll
                for (int n = 0; n < 2; ++n) acc[a][b][m][n] = (f32x4){0.f, 0.f, 0.f, 0.f};
    bf16x8 At[4][2], B0[2][2], B1[2][2];
    const char* cA = (const char*)g.A + (size_t)cur.pm * tstep + (size_t)cur.k0 * 2; const char* cB = (const char*)g.Bt + (size_t)cur.pn * tstep + (size_t)cur.k0 * 2;
    S.a_ready(cur);
    if constexpr (SP2) {
        PG8_STAGE(PG8_SB(0, 0), cB, voffB); PG8_STAGE(PG8_SB(0, 1), cB + hstep, voffB); PG8_STAGE(PG8_SA(0, 0), cA, voffA); PG8_STAGE(PG8_SA(0, 1), cA + hstep, voffA);
        if (wr == 1) PG8_BAR;
        PG8_WAIT_V(2); PG8_BAR;
        PG8_STAGE(PG8_SB(1, 0), cB + kstep, voffB); PG8_STAGE(PG8_SA(1, 0), cA + kstep, voffA); PG8_STAGE(PG8_SB(1, 1), cB + hstep + kstep, voffB);
        PG8_WAIT_V(6); PG8_BAR;
    } else {
        PG8_STAGE(PG8_SB(0, 0), cB, voffB); PG8_STAGE(PG8_SA(0, 0), cA, voffA); PG8_STAGE(PG8_SB(0, 1), cB + hstep, voffB); PG8_STAGE(PG8_SA(0, 1), cA + hstep, voffA);
        if (wr == 1) PG8_BAR;
        PG8_WAIT_V(4); PG8_BAR;
        PG8_STAGE(PG8_SB(1, 0), cB + kstep, voffB); PG8_STAGE(PG8_SA(1, 0), cA + kstep, voffA); PG8_STAGE(PG8_SB(1, 1), cB + hstep + kstep, voffB);
        PG8_WAIT_V(6); PG8_BAR;
    }
    for (;;) {
        const bool has_next = S.next(ui + 1, nxt);
        const char* nA = has_next ? (const char*)g.A + (size_t)nxt.pm * tstep + (size_t)nxt.k0 * 2 : cA; const char* nB = has_next ? (const char*)g.Bt + (size_t)nxt.pn * tstep + (size_t)nxt.k0 * 2 : cB;
        const int nt = cur.nt ? cur.nt : K / BK;
        for (int t = 0; t < nt; t += 2) {
            const bool last = (t == nt - 2);
            const char* a1 = cA + (size_t)(t + 1) * kstep;
            const char* a2 = last ? nA : cA + (size_t)(t + 2) * kstep; const char* b2 = last ? nB : cB + (size_t)(t + 2) * kstep;
            const char* a3 = a2 + kstep; const char* b3 = b2 + kstep;
            if (last && has_next) S.a_ready(nxt);
            if constexpr (SP2) {
            PG8_LDB(B0, 0, 0); PG8_LDB(B1, 0, 1); PG8_SCHED; PG8_LDA(At, 0, 0); PG8_STAGE(PG8_SA(1, 1), a1 + hstep, voffA);
            PG8_WAIT_V(8); PG8_WAIT_L(0); PG8_BAR; PG8_MMA(0, 0, At, B0); PG8_MMA(0, 1, At, B1); PG8_BAR; PG8_SCHED;
            PG8_LDA(At, 0, 1); PG8_STAGE(PG8_SB(0, 0), b2, voffB); PG8_STAGE(PG8_SB(0, 1), b2 + hstep, voffB); PG8_STAGE(PG8_SA(0, 0), a2, voffA);
            PG8_WAIT_V(8); PG8_WAIT_L(0); PG8_BAR; PG8_MMA(1, 0, At, B0); PG8_MMA(1, 1, At, B1); PG8_BAR; PG8_SCHED;
            PG8_LDB(B0, 1, 0); PG8_LDB(B1, 1, 1); PG8_SCHED; PG8_LDA(At, 1, 0); PG8_STAGE(PG8_SA(0, 1), a2 + hstep, voffA);
            PG8_WAIT_V(8); PG8_WAIT_L(0); PG8_BAR; PG8_MMA(0, 0, At, B0); PG8_MMA(0, 1, At, B1); PG8_BAR; PG8_SCHED;
            PG8_LDA(At, 1, 1); PG8_STAGE(PG8_SB(1, 0), b3, voffB); PG8_STAGE(PG8_SB(1, 1), b3 + hstep, voffB); PG8_STAGE(PG8_SA(1, 0), a3, voffA);
            PG8_WAIT_V(8); PG8_WAIT_L(0); PG8_BAR; PG8_MMA(1, 0, At, B0); PG8_MMA(1, 1, At, B1); PG8_BAR; PG8_SCHED;
            } else {
            PG8_LDB(B0, 0, 0); PG8_SCHED; PG8_LDA(At, 0, 0); PG8_STAGE(PG8_SA(1, 1), a1 + hstep, voffA);
            PG8_WAIT_L(8); PG8_BAR; PG8_WAIT_L(0); PG8_MMA(0, 0, At, B0); PG8_BAR; PG8_SCHED;
            PG8_LDB(B1, 0, 1); PG8_STAGE(PG8_SB(0, 0), b2, voffB);
            PG8_BAR; PG8_WAIT_L(0); PG8_MMA(0, 1, At, B1); PG8_BAR;
            PG8_LDA(At, 0, 1); PG8_STAGE(PG8_SA(0, 0), a2, voffA);
            PG8_BAR; PG8_WAIT_L(0); PG8_MMA(1, 0, At, B0); PG8_BAR; PG8_SCHED;
            PG8_STAGE(PG8_SB(0, 1), b2 + hstep, voffB);
            PG8_WAIT_V(6); PG8_BAR; PG8_MMA(1, 1, At, B1); PG8_BAR;
            PG8_LDB(B0, 1, 0); PG8_SCHED; PG8_LDA(At, 1, 0); PG8_STAGE(PG8_SA(0, 1), a2 + hstep, voffA);
            PG8_WAIT_L(8); PG8_BAR; PG8_WAIT_L(0); PG8_MMA(0, 0, At, B0); PG8_BAR; PG8_SCHED;
            PG8_LDB(B1, 1, 1); PG8_STAGE(PG8_SB(1, 0), b3, voffB);
            PG8_BAR; PG8_WAIT_L(0); PG8_MMA(0, 1, At, B1); PG8_BAR;
            PG8_LDA(At, 1, 1); PG8_STAGE(PG8_SA(1, 0), a3, voffA);
            PG8_BAR; PG8_WAIT_L(0); PG8_MMA(1, 0, At, B0); PG8_BAR; PG8_SCHED;
            PG8_STAGE(PG8_SB(1, 1), b3 + hstep, voffB);
            PG8_WAIT_V(6); PG8_BAR; PG8_MMA(1, 1, At, B1); PG8_BAR;
            }
        }
        if constexpr (ALIGN_EPI) { if (wr == 0) PG8_BAR; }
        if constexpr (!Epi::AFTER_DRAIN) { E(acc, cur, wr, wc, fr, fq); S.done(cur); }
        if (!has_next) break;
#pragma unroll
        for (int a = 0; a < 2; ++a)
#pragma unroll
            for (int b = 0; b < 2; ++b)
#pragma unroll
                for (int m = 0; m < 4; ++m)
#pragma unroll
                    for (int n = 0; n < 2; ++n) acc[a][b][m][n] = (f32x4){0.f, 0.f, 0.f, 0.f};
        cur = nxt; cA = nA; cB = nB; ++ui;
        if constexpr (ALIGN_EPI) { if (wr == 1) PG8_BAR; }
    }
    PG8_WAIT_V(0);
    if constexpr (!ALIGN_EPI) { if (wr == 0) PG8_BAR; }
    PG8_BAR;
    if constexpr (Epi::AFTER_DRAIN) { E.fused(acc, cur, wr, wc, fr, fq, lds, wid, lane); S.done(cur); }
#undef PG8_SA
#undef PG8_SB
#undef PG8_STAGE
#undef PG8_LDA
#undef PG8_LDB
#undef PG8_MMA
#undef PG8_WAIT_V
#undef PG8_WAIT_L
#undef PG8_BAR
#undef PG8_SCHED
}
}
#define XB_TMO      128
#define XB_XCNT(j)  (256  + 64 * (j))
#define XB_XSUB(j)  (1280 + 64 * (j))
#define XB_XGEN(j)  (2304 + 64 * (j))
#define XB_TOP      3328
#define XB_TOPGEN   3392
#define XCD_BAR_WORDS 3456
#define XB_SPIN_CAP (1u << 18)

__device__ __forceinline__ unsigned xb_ld(unsigned* p)              { return __hip_atomic_load(p, __ATOMIC_RELAXED, __HIP_MEMORY_SCOPE_AGENT); }
__device__ __forceinline__ unsigned xb_add(unsigned* p, unsigned v) { return __hip_atomic_fetch_add(p, v, __ATOMIC_RELAXED, __HIP_MEMORY_SCOPE_AGENT); }
__device__ __forceinline__ unsigned xb_xcc_id() { return (unsigned)__builtin_amdgcn_s_getreg((3 << 11) | 20) & 0xFu; }
#define XB_SPIN(cond, bar) do { unsigned _sp = 0; while (cond) { __builtin_amdgcn_s_sleep(1); \
    if ((++_sp & 255u) == 0u) { if (xb_ld(&(bar)[XB_TMO])) break; if (_sp > XB_SPIN_CAP) { atomicAdd(&(bar)[XB_TMO], 1u); break; } } } } while (0)

struct XcdBarrier {
    unsigned* bar; unsigned x;
    volatile LAS unsigned* st;
};

__device__ __forceinline__ XcdBarrier xcd_barrier_post(unsigned* bar, volatile LAS unsigned* st) {
    XcdBarrier b; b.bar = bar; b.x = xb_xcc_id(); b.st = st;
    if (threadIdx.x == 0) (void)xb_add(&bar[XB_XCNT(b.x)], 1u);
    return b;
}
__device__ __forceinline__ void xcd_barrier_complete(unsigned* bar, unsigned x, unsigned& nloc, unsigned& nx) {
    const unsigned G = gridDim.x * gridDim.y * gridDim.z;
    unsigned sum, cnt, mine, sp = 0u;
    for (;;) {
        sum = 0u; cnt = 0u; mine = 0u;
#pragma unroll
        for (unsigned j = 0; j < 16; ++j) { const unsigned c = xb_ld(&bar[XB_XCNT(j)]); sum += c; cnt += (c > 0u) ? 1u : 0u; mine = (j == x) ? c : mine; }
        if (sum == G) break;
        __builtin_amdgcn_s_sleep(1);
        if ((++sp & 255u) == 0u) { if (xb_ld(&bar[XB_TMO])) break; if (sp > XB_SPIN_CAP) { atomicAdd(&bar[XB_TMO], 1u); break; } }
    }
    nloc = mine > 0u ? mine : 1u; nx = cnt > 0u ? cnt : 1u;
}

__device__ __forceinline__ void xcd_barrier(const XcdBarrier& b) {
    asm volatile("s_waitcnt vmcnt(0)" ::: "memory");
    __syncthreads();
    if (threadIdx.x == 0) {
        unsigned* bar = b.bar;
        __builtin_amdgcn_s_waitcnt(0);
        unsigned nloc = b.st[0], nx = b.st[1];
        if (nloc == 0u) { xcd_barrier_complete(bar, b.x, nloc, nx); b.st[0] = nloc; b.st[1] = nx; }
        const unsigned old = xb_add(&bar[XB_XSUB(b.x)], 1u);
        const unsigned gen = old / nloc;
        if (old + 1u == (gen + 1u) * nloc) {
            __builtin_amdgcn_fence(__ATOMIC_RELEASE, "agent");
            asm volatile("s_waitcnt vmcnt(0)" ::: "memory");
            const unsigned og = xb_add(&bar[XB_TOP], 1u);
            const unsigned tg = og / nx;
            if (og + 1u == (tg + 1u) * nx) xb_add(&bar[XB_TOPGEN], 1u);
            else XB_SPIN(xb_ld(&bar[XB_TOPGEN]) == tg, bar);
            __builtin_amdgcn_fence(__ATOMIC_ACQUIRE, "agent");
            xb_add(&bar[XB_XGEN(b.x)], 1u);
            asm volatile("s_waitcnt vmcnt(0)" ::: "memory");
        } else {
            XB_SPIN(xb_ld(&bar[XB_XGEN(b.x)]) == gen, bar);
            __builtin_amdgcn_fence(__ATOMIC_ACQUIRE, "agent");
            asm volatile("s_waitcnt vmcnt(0)" ::: "memory");
        }
    }
    __syncthreads();
}


typedef __bf16 bf16x2_t __attribute__((ext_vector_type(2)));
__device__ __forceinline__ unsigned cvtpk(float lo, float hi) { f32x2 v = {lo, hi}; bf16x2_t b = __builtin_convertvector(v, bf16x2_t); return __builtin_bit_cast(unsigned, b); }
__device__ __forceinline__ float wave_sum(float v) {
#pragma unroll
    for (int o = 1; o < 64; o <<= 1) v += __shfl_xor(v, o);
    return v;
}
__device__ __forceinline__ float silu_f(float x) { return x / (1.f + __expf(-x)); }
__device__ __forceinline__ float logsigmoid_f(float z) { return fminf(z, 0.f) - __logf(1.f + __expf(-fabsf(z))); }
__device__ __forceinline__ int cond_of_row(int r) { return r < T_P ? 0 : 1 + ((r - T_P) >> 10); }
__device__ __forceinline__ int clampi(int v, int lo, int hi) { return v < lo ? lo : (v > hi ? hi : v); }

#ifndef ADA_DEFER
#define ADA_DEFER 1
#endif
#ifndef EPI_NT
#define EPI_NT 0
#endif
__device__ __forceinline__ void st16(void* p, u32x4 w) {
    if (EPI_NT == 2) asm volatile("global_store_dwordx4 %0, %1, off sc0 sc1" :: "v"(p), "v"(w) : "memory");
    else if (EPI_NT == 1) __builtin_nontemporal_store(w, (u32x4*)p); else *(u32x4*)p = w; }
struct Args { const float* in[21]; float* out; unsigned char* ws; int ph_lo, ph_hi; };
enum { IN_XP = 0, IN_XS, IN_CK, IN_CV, IN_SG, IN_C, IN_CCTX, IN_WADA, IN_BADA, IN_NORMG, IN_WQKV, IN_WONA, IN_RPB, IN_WQKVG, IN_WA1, IN_WA2, IN_BA, IN_GHEAD, IN_WOGLA, IN_W1, IN_W2 };
constexpr int PH_PRO = 0, PH_R0 = 1, PH_L0 = 2, PH_PER_LAYER = 8, NPH = PH_L0 + NL * PH_PER_LAYER;
enum { LP_MIX = 0, LP_CORE, LP_GATE, LP_WO, LP_ROWMID, LP_W1, LP_W2, LP_ROWEND };

struct E8NaQK {
    bf16* QK; float* newk; int li;
    __device__ __forceinline__ void store8(int row, int col, const float (&v)[8]) const {
        u32x4 w; w.x = cvtpk(v[0], v[1]); w.y = cvtpk(v[2], v[3]); w.z = cvtpk(v[4], v[5]); w.w = cvtpk(v[6], v[7]);
        { const int kpart = col >= 2048, c = col - 2048 * kpart, h = c >> 7, d = c & 127;
          st16(QK + (size_t)kpart * T * 2048 + ((size_t)h * T + row) * 128 + d, w); }
        if (col >= 2048 && row < T_P) {
            const int b = row >> 8, s = row & 255, c = col - 2048, h = c >> 7, d = c & 127;
            float* p = newk + ((((size_t)b * 2 + li) * 16 + h) * 256 + s) * 128 + d;
            *(f32x4*)p = (f32x4){v[0], v[1], v[2], v[3]}; *(f32x4*)(p + 4) = (f32x4){v[4], v[5], v[6], v[7]};
        }
    }
};
struct E8VT {
    bf16* VT; float* newv; int li;
    __device__ __forceinline__ void store8(int row, int col, const float (&v)[8]) const {
        u32x4 w; w.x = cvtpk(v[0], v[1]); w.y = cvtpk(v[2], v[3]); w.z = cvtpk(v[4], v[5]); w.w = cvtpk(v[6], v[7]);
        st16(VT + (size_t)row * VTP + col, w);
        if (newv && col < T_P) {
            const int b = col >> 8, s = col & 255, h = row >> 7, d = row & 127;
            float* p = newv + ((((size_t)b * 2 + li) * 16 + h) * 256 + s) * 128 + d;
#pragma unroll
            for (int e = 0; e < 8; ++e) p[(size_t)e * 128] = v[e];
        }
    }
};
struct E8GlaQKG {
    bf16* QK; float* TLR;
    __device__ __forceinline__ void store8(int row, int col, const float (&v)[8]) const {
        if (col < 4096) {
            u32x4 w; w.x = cvtpk(v[0], v[1]); w.y = cvtpk(v[2], v[3]); w.z = cvtpk(v[4], v[5]); w.w = cvtpk(v[6], v[7]);
            st16(QK + (size_t)row * 4096 + col, w);
        } else if (col < 4128) {
            float* p = TLR + (size_t)row * 32 + (col - 4096);
            *(f32x4*)p = (f32x4){v[0], v[1], v[2], v[3]}; *(f32x4*)(p + 4) = (f32x4){v[4], v[5], v[6], v[7]};
        }
    }
};
struct E8F32 {
    float* Y; int ldc;
    __device__ __forceinline__ void store8(int row, int col, const float (&v)[8]) const {
        float* p = Y + (size_t)row * ldc + col;
        *(f32x4*)p = (f32x4){v[0], v[1], v[2], v[3]}; *(f32x4*)(p + 4) = (f32x4){v[4], v[5], v[6], v[7]};
    }
};
struct E8Bf16 {
    bf16* O; int ldc;
    __device__ __forceinline__ void store8(int row, int col, const float (&v)[8]) const {
        u32x4 w; w.x = cvtpk(v[0], v[1]); w.y = cvtpk(v[2], v[3]); w.z = cvtpk(v[4], v[5]); w.w = cvtpk(v[6], v[7]);
        st16(O + (size_t)row * ldc + col, w);
    }
};
struct E8Relu2 {
    bf16* O; int ldc;
    __device__ __forceinline__ void store8(int row, int col, const float (&v)[8]) const {
        float r[8];
#pragma unroll
        for (int e = 0; e < 8; ++e) { const float t = fmaxf(v[e], 0.f); r[e] = t * t; }
        u32x4 w; w.x = cvtpk(r[0], r[1]); w.y = cvtpk(r[2], r[3]); w.z = cvtpk(r[4], r[5]); w.w = cvtpk(r[6], r[7]);
        st16(O + (size_t)row * ldc + col, w);
    }
};
template <class E8> struct EpiWrap {
    static constexpr bool PERM = true, AFTER_DRAIN = false;
    E8 e;
    __device__ __forceinline__ void operator()(const pg8::f32x4 (&acc)[2][2][4][2], const pg8::Unit& u, int wr, int wc, int fr, int fq) const {
        const int row0 = u.pm * 256 + wr * 64 + fr, col0 = u.pn * 256 + wc * 32 + 8 * fq;
#pragma unroll
        for (int ai = 0; ai < 2; ++ai)
#pragma unroll
            for (int m = 0; m < 4; ++m)
#pragma unroll
                for (int bj = 0; bj < 2; ++bj) {
                    const pg8::f32x4 a = acc[ai][bj][m][0], b = acc[ai][bj][m][1];
                    const float v[8] = {a[0], a[1], a[2], a[3], b[0], b[1], b[2], b[3]};
                    e.store8(row0 + ai * 128 + m * 16, col0 + bj * 128, v);
                }
    }
};

constexpr int W2_NT_MAIN = 100;
struct SplitKOrder {
    int c;
    __device__ static void map(int L, pg8::Unit& u) {
        const int nM = 24, nN = 8, nwg = 192;
        int wgid = L; { const int q = nwg / 8, xcd = wgid % 8, off = wgid / 8; wgid = xcd * q + off; }
        const int nig = 8 * nN, gid = wgid / nig, fm = gid * 8, gsz = (nM - fm) < 8 ? (nM - fm) : 8;
        u.pm = fm + ((wgid % nig) % gsz); u.pn = (wgid % nig) / gsz;
    }
    __device__ bool next(int i, pg8::Unit& u) const {
        if (c < 192) { if (i > 0) return false; map(c, u); u.k0 = 0; u.nt = W2_NT_MAIN; u.part = 0; return true; }
        if (i >= 3) return false;
        map(3 * (c - 192) + i, u); u.k0 = W2_NT_MAIN * 64; u.nt = 128 - W2_NT_MAIN; u.part = 1; return true;
    }
    __device__ __forceinline__ void a_ready(const pg8::Unit&) const {}
    __device__ __forceinline__ void done(const pg8::Unit&) const {}
};
struct EpiF32Part {
    static constexpr bool PERM = true, AFTER_DRAIN = false;
    float* Y0; float* Y1;
    __device__ __forceinline__ void operator()(const pg8::f32x4 (&acc)[2][2][4][2], const pg8::Unit& u, int wr, int wc, int fr, int fq) const {
        const int row0 = u.pm * 256 + wr * 64 + fr, col0 = u.pn * 256 + wc * 32 + 8 * fq;
        float* Y = u.part ? Y1 : Y0;
#pragma unroll
        for (int ai = 0; ai < 2; ++ai)
#pragma unroll
            for (int m = 0; m < 4; ++m)
#pragma unroll
                for (int bj = 0; bj < 2; ++bj) {
                    float* p = Y + (size_t)(row0 + ai * 128 + m * 16) * D + col0 + bj * 128;
                    *(f32x4*)p = acc[ai][bj][m][0]; *(f32x4*)(p + 4) = acc[ai][bj][m][1];
                }
    }
};

__device__ __forceinline__ void tr_item(const float* src, size_t ldsrc, bf16* dst, size_t lddst, LAS float* scr, int lane) {
    const float* sp_ = src + (size_t)(lane >> 5) * ldsrc + (lane & 31); LAS float* dp_ = scr + (lane >> 5) * 33 + (lane & 31);
#pragma unroll 1
    for (int h = 0; h < 2; ++h, sp_ += 32 * ldsrc, dp_ += 32 * 33) {
        float tv[16];
#pragma unroll
        for (int i = 0; i < 16; ++i) tv[i] = __builtin_nontemporal_load(sp_ + (size_t)(2 * i) * ldsrc);
#pragma unroll
        for (int i = 0; i < 16; ++i) dp_[2 * i * 33] = tv[i];
    }
    LDS_WAIT(); asm volatile("" ::: "memory");
    const int c = lane & 7;
#pragma unroll
    for (int j = 0; j < 4; ++j) { const int n = (lane >> 3) + 8 * j; const LAS float* s = scr + (8 * c) * 33 + n;
        u32x4 o; o.x = cvtpk(s[0 * 33], s[1 * 33]); o.y = cvtpk(s[2 * 33], s[3 * 33]); o.z = cvtpk(s[4 * 33], s[5 * 33]); o.w = cvtpk(s[6 * 33], s[7 * 33]);
        *(u32x4*)(dst + (size_t)n * lddst + 8 * c) = o; }
    LDS_WAIT(); asm volatile("" ::: "memory");
}
constexpr int PRO_SCR_BYTES = 8448, PRO_SILU_OFF = 8 * PRO_SCR_BYTES  , PRO_PART_OFF = PRO_SILU_OFF + 3 * 2048 * 4  ;
constexpr int LY_ADA = 192, LY_TR = 3072, LY_A1 = 32, LY_ITEMS = LY_ADA + LY_TR + LY_A1;

__device__ __forceinline__ void silu_table(const Args& a, LAS unsigned char* lds, int tid) {
    LAS float* sil = (LAS float*)(lds + PRO_SILU_OFF);
    for (int e = tid; e < 3 * 2048; e += 512) { const int c = e >> 11, k = e & 2047; const float x = c == 0 ? a.in[IN_CCTX][k] : a.in[IN_C][(c - 1) * 2048 + k]; sil[e] = silu_f(x); }
    __syncthreads();
}
__device__ __forceinline__ void ada_layer(const Args& a, LAS unsigned char* lds, int l, int b0, int nb, int tid) {
    const int lane = tid & 63, wave = __builtin_amdgcn_readfirstlane(tid >> 6);
    LAS float* sil = (LAS float*)(lds + PRO_SILU_OFF);
    LAS float* part = (LAS float*)(lds + PRO_PART_OFF);
    for (int cg = b0; cg < LY_ADA; cg += nb) {
        const float* W = a.in[IN_WADA] + (size_t)l * 2048 * 12288 + cg * 64 + lane;
        float a0 = 0.f, a1 = 0.f, a2 = 0.f;
        const int k0 = wave * 256;
#pragma unroll 1
        for (int kc = 0; kc < 256; kc += 16) {
            float wv[16];
#pragma unroll
            for (int k = 0; k < 16; ++k) wv[k] = __builtin_nontemporal_load(W + (size_t)(k0 + kc + k) * 12288);
#pragma unroll
            for (int k = 0; k < 16; ++k) { a0 += sil[k0 + kc + k] * wv[k]; a1 += sil[2048 + k0 + kc + k] * wv[k]; a2 += sil[4096 + k0 + kc + k] * wv[k]; }
        }
        part[(wave * 3 + 0) * 64 + lane] = a0; part[(wave * 3 + 1) * 64 + lane] = a1; part[(wave * 3 + 2) * 64 + lane] = a2;
        __syncthreads();
        if (tid < 192) { const int c = tid >> 6, col = tid & 63; float sacc = 0.f;
#pragma unroll
            for (int w = 0; w < 8; ++w) sacc += part[(w * 3 + c) * 64 + col];
            ((float*)(a.ws + WS_MOD))[((size_t)l * 3 + c) * 12288 + cg * 64 + col] = sacc + a.in[IN_BADA][l * 12288 + cg * 64 + col]; }
        __syncthreads();
    }
}
__device__ __forceinline__ void convert_weights(const Args& a, LAS unsigned char* lds, int l, int it_lo, int it_hi, int b0, int nb, int tid) {
    const int lane = tid & 63, wave = __builtin_amdgcn_readfirstlane(tid >> 6);
    LAS float* scr = (LAS float*)(lds + wave * PRO_SCR_BYTES);
    unsigned char* ws = a.ws;
    const int i = l >> 1; const bool gla = l & 1;
    for (int it = it_lo + b0; it < it_hi; it += nb) {
        int r = it;
        if (r < LY_TR) {
            if (r < 768) {
                const int kb = r / 24, nb2 = r % 24;
                const float* src = (gla ? a.in[IN_WQKVG] : a.in[IN_WQKV]) + (size_t)i * 2048 * 6144;
                int db = nb2; if (gla) { if (nb2 >= 16) db = 8 + (nb2 - 16); else if (nb2 >= 8) db = 17 + (nb2 - 8); }
                bf16* dst = (bf16*)(ws + WS_WMIX) + (size_t)l * NMIX * D;
                tr_item(src + (size_t)(kb * 64) * 6144 + nb2 * 256 + wave * 32, 6144, dst + (size_t)(db * 256 + wave * 32) * D + kb * 64, D, scr, lane);
            } else if (r < 1024) {
                r -= 768; const int kb = r / 8, nb2 = r % 8;
                const float* src = (gla ? a.in[IN_WOGLA] : a.in[IN_WONA]) + (size_t)i * 2048 * 2048;
                bf16* dst = (bf16*)(ws + WS_WO) + (size_t)l * D * D;
                tr_item(src + (size_t)(kb * 64) * 2048 + nb2 * 256 + wave * 32, 2048, dst + (size_t)(nb2 * 256 + wave * 32) * D + kb * 64, D, scr, lane);
            } else if (r < 2048) {
                r -= 1024; const int kb = r / 32, nb2 = r % 32;
                const float* src = a.in[IN_W1] + (size_t)l * 2048 * 8192;
                bf16* dst = (bf16*)(ws + WS_W1) + (size_t)l * FF * D;
                tr_item(src + (size_t)(kb * 64) * 8192 + nb2 * 256 + wave * 32, 8192, dst + (size_t)(nb2 * 256 + wave * 32) * D + kb * 64, D, scr, lane);
            } else {
                r -= 2048; const int kb = r / 8, nb2 = r % 8;
                const float* src = a.in[IN_W2] + (size_t)l * 8192 * 2048;
                bf16* dst = (bf16*)(ws + WS_W2) + (size_t)l * D * FF;
                tr_item(src + (size_t)(kb * 64) * 2048 + nb2 * 256 + wave * 32, 2048, dst + (size_t)(nb2 * 256 + wave * 32) * FF + kb * 64, FF, scr, lane);
            }
            continue;
        }
        r -= LY_TR;
        if (gla) {
            const int p = r;
            bf16* dst = (bf16*)(ws + WS_WMIX) + (size_t)l * NMIX * D + (size_t)4096 * D;
            for (int q = 0; q < 32; ++q) { const int e = tid + 512 * q, rr = e >> 11, k = e & 2047, prow = 8 * p + rr;
                float val = 0.f; if (prow < 32) val = a.in[IN_WA1][(((size_t)i * 2 + (prow >> 4)) * 2048 + k) * 16 + (prow & 15)];
                dst[(size_t)prow * D + k] = (bf16)f2bf(val); }
        }
    }
}
constexpr int CV_WITEMS = LY_TR + LY_A1;
#ifndef CVMIX
#define CVMIX 1100
#define CVWO 1500
#define CVW2 3104
#endif
constexpr int CV_MIX_END = CVMIX, CV_WO_END = CVWO, CV_W2_END = CVW2;
constexpr int PRO_CK = 512, PRO_CV = 128;
__device__ __forceinline__ void prologue_phase(const Args& a, LAS unsigned char* lds, int bid, int G, int tid) {
    const int lane = tid & 63, wave = __builtin_amdgcn_readfirstlane(tid >> 6);
    LAS float* scr = (LAS float*)(lds + wave * PRO_SCR_BYTES);
    unsigned char* ws = a.ws;
    silu_table(a, lds, tid);
    const bool defer = (G == 256);
    for (int l = 0; l < ((ADA_DEFER && defer) ? 1 : NL); ++l) ada_layer(a, lds, l, (bid + 64 * l) % G, G, tid);
    convert_weights(a, lds, 0, 0, CV_WITEMS, bid, G, tid);
    for (int l = 1; l < NL; ++l) convert_weights(a, lds, l, defer ? CV_W2_END : 0, CV_WITEMS, (bid + 37 * l) % G, G, tid);
    for (int r = bid; r < PRO_CK + PRO_CV; r += G) {
        if (r < PRO_CK) {
            const size_t e0 = ((size_t)r * 512 + tid) * 8;
            const f32x4 x0 = *(const f32x4*)(a.in[IN_CK] + e0), x1 = *(const f32x4*)(a.in[IN_CK] + e0 + 4);
            u32x4 w; w.x = cvtpk(x0[0], x0[1]); w.y = cvtpk(x0[2], x0[3]); w.z = cvtpk(x1[0], x1[1]); w.w = cvtpk(x1[2], x1[3]);
            *(u32x4*)((bf16*)(ws + WS_CK) + e0) = w;
        } else {
            const int rr = r - PRO_CK, mat = rr >> 1, kh = rr & 1, kb = kh * 2 + (wave >> 2), nb2 = wave & 3;
            tr_item(a.in[IN_CV] + (size_t)mat * 256 * 128 + (size_t)(kb * 64) * 128 + nb2 * 32, 128, (bf16*)(ws + WS_CVT) + (size_t)mat * 128 * 256 + (size_t)(nb2 * 32) * 256 + kb * 64, 256, scr, lane);
        }
    }
}

template <bool FIRST, bool UPD, bool EMIT, bool ADD2 = false>
__device__ __forceinline__ void row_phase(const Args& a, int gw, int ngw, int lane, const float* ga, const float* modU, int jgate, const float* gb, const float* modE, int jshift, int jscale) {
    float* X = a.out + OUT_X; const float* Y = (const float*)(a.ws + WS_Y); bf16* H = (bf16*)(a.ws + WS_H);
    const int rpw = (T + ngw - 1) / ngw, r0 = gw * rpw, r1 = (r0 + rpw < T) ? r0 + rpw : T;
    f32x4 c1[8], c2[8], c3[8];
    int cur = -1;
    for (int r = r0; r < r1; ++r) {
        const int cond = cond_of_row(r);
        if (cond != cur) {
            cur = cond;
            if (UPD) { const float* gate = modU + ((size_t)cond * 6 + jgate) * D;
#pragma unroll
                for (int j = 0; j < 8; ++j) c1[j] = *(const f32x4*)(gate + 256 * j + 4 * lane) * *(const f32x4*)(ga + 256 * j + 4 * lane); }
            if (EMIT) { const float* sh = modE + ((size_t)cond * 6 + jshift) * D; const float* sc = modE + ((size_t)cond * 6 + jscale) * D;
#pragma unroll
                for (int j = 0; j < 8; ++j) { c2[j] = *(const f32x4*)(gb + 256 * j + 4 * lane) * (*(const f32x4*)(sc + 256 * j + 4 * lane) + 1.f); c3[j] = *(const f32x4*)(sh + 256 * j + 4 * lane); } }
        }
        const float* xin = FIRST ? (r < T_P ? a.in[IN_XP] + (size_t)r * D : a.in[IN_XS] + (size_t)(r - T_P) * D) : X + (size_t)r * D;
        f32x4 x[8];
#pragma unroll
        for (int j = 0; j < 8; ++j) x[j] = *(const f32x4*)(xin + 256 * j + 4 * lane);
        if (UPD) {
            f32x4 y[8]; float ss = 0.f;
#pragma unroll
            for (int j = 0; j < 8; ++j) {
                if (Y_BF16) { const u32x2 yw = *(const u32x2*)((const bf16*)Y + (size_t)r * D + 256 * j + 4 * lane); y[j] = (f32x4){bflo(yw.x), bfhi(yw.x), bflo(yw.y), bfhi(yw.y)}; }
                else { y[j] = *(const f32x4*)(Y + (size_t)r * D + 256 * j + 4 * lane); if (ADD2) y[j] = y[j] + *(const f32x4*)(Y + (size_t)T * D + (size_t)r * D + 256 * j + 4 * lane); }
                ss += (y[j][0] * y[j][0] + y[j][1] * y[j][1]) + (y[j][2] * y[j][2] + y[j][3] * y[j][3]); }
            const float rinv = rsqrtf(wave_sum(ss) * (1.f / D) + EPS);
#pragma unroll
            for (int j = 0; j < 8; ++j) x[j] = x[j] + c1[j] * (y[j] * rinv);
        }
        if (FIRST || UPD) {
#pragma unroll
            for (int j = 0; j < 8; ++j) *(f32x4*)(X + (size_t)r * D + 256 * j + 4 * lane) = x[j];
        }
        if (EMIT) {
            float ss = 0.f;
#pragma unroll
            for (int j = 0; j < 8; ++j) ss += (x[j][0] * x[j][0] + x[j][1] * x[j][1]) + (x[j][2] * x[j][2] + x[j][3] * x[j][3]);
            const float rinv = rsqrtf(wave_sum(ss) * (1.f / D) + EPS);
#pragma unroll
            for (int j = 0; j < 8; ++j) { const f32x4 h = (x[j] * rinv) * c2[j] + c3[j];
                u32x2 w; w.x = cvtpk(h[0], h[1]); w.y = cvtpk(h[2], h[3]);
                *(u32x2*)(H + (size_t)r * D + 256 * j + 4 * lane) = w; }
        }
    }
}

__device__ __forceinline__ void gla_gate_phase(const Args& a, int gw, int ngw, int lane, int li) {
    const float* OG = (const float*)(a.ws + WS_OG); const bf16* QK = (const bf16*)(a.ws + WS_QK); bf16* AO = (bf16*)(a.ws + WS_AO);
    const float* gh = a.in[IN_GHEAD] + (size_t)li * 512;
    for (int r = gw; r < T; r += ngw) {
        f32x4 o[8];
#pragma unroll
        for (int j = 0; j < 8; ++j) {
            if (OG_BF16) { const bf16* og = (const bf16*)OG; const u32x2 p0 = *(const u32x2*)(og + (size_t)r * D + 256 * j + 4 * lane), p1 = *(const u32x2*)(og + (size_t)T * D + (size_t)r * D + 256 * j + 4 * lane);
                o[j] = (f32x4){bflo(p0.x) + bflo(p1.x), bfhi(p0.x) + bfhi(p1.x), bflo(p0.y) + bflo(p1.y), bfhi(p0.y) + bfhi(p1.y)}; }
            else o[j] = *(const f32x4*)(OG + (size_t)r * D + 256 * j + 4 * lane) + *(const f32x4*)(OG + (size_t)T * D + (size_t)r * D + 256 * j + 4 * lane);
        }
#pragma unroll
        for (int hh = 0; hh < 4; ++hh) {
            float ss = 0.f;
#pragma unroll
            for (int jj = 0; jj < 2; ++jj) { const f32x4 v = o[2 * hh + jj]; ss += (v[0] * v[0] + v[1] * v[1]) + (v[2] * v[2] + v[3] * v[3]); }
            const float rinv = rsqrtf(wave_sum(ss) * (1.f / 512.f) + EPS);
#pragma unroll
            for (int jj = 0; jj < 2; ++jj) { const int j = 2 * hh + jj, c = 256 * j + 4 * lane;
                const f32x4 g = *(const f32x4*)(gh + (c & 511));
                const u32x2 gw2 = *(const u32x2*)(QK + (size_t)r * 4096 + 2048 + c);
                const float g0 = bflo(gw2.x), g1 = bfhi(gw2.x), g2 = bflo(gw2.y), g3 = bfhi(gw2.y);
                const f32x4 v = o[j] * rinv * g;
                u32x2 w; w.x = cvtpk(v[0] * silu_f(g0), v[1] * silu_f(g1)); w.y = cvtpk(v[2] * silu_f(g2), v[3] * silu_f(g3));
                *(u32x2*)(AO + (size_t)r * D + c) = w; }
        }
    }
}

template <class E8> __global__ __launch_bounds__(256) void ref_gemm(const bf16* A, const bf16* Bt, int M, int N, int K, E8 E) {
    __shared__ __attribute__((aligned(16))) float As[32][68]; __shared__ __attribute__((aligned(16))) float Bs[32][68];
    const int t = threadIdx.x, m0 = blockIdx.y * 64, n0 = blockIdx.x * 64, lr = t >> 2, lk = (t & 3) * 8, ty = t >> 3, tx = t & 7;
    float acc[2][8];
#pragma unroll
    for (int i = 0; i < 2; ++i)
#pragma unroll
        for (int j = 0; j < 8; ++j) acc[i][j] = 0.f;
    for (int k0 = 0; k0 < K; k0 += 32) {
        const u32x4 av = *(const u32x4*)(A + (size_t)(m0 + lr) * K + k0 + lk), bv = *(const u32x4*)(Bt + (size_t)(n0 + lr) * K + k0 + lk);
        __syncthreads();
        As[lk + 0][lr] = bflo(av.x); As[lk + 1][lr] = bfhi(av.x); As[lk + 2][lr] = bflo(av.y); As[lk + 3][lr] = bfhi(av.y); As[lk + 4][lr] = bflo(av.z); As[lk + 5][lr] = bfhi(av.z); As[lk + 6][lr] = bflo(av.w); As[lk + 7][lr] = bfhi(av.w);
        Bs[lk + 0][lr] = bflo(bv.x); Bs[lk + 1][lr] = bfhi(bv.x); Bs[lk + 2][lr] = bflo(bv.y); Bs[lk + 3][lr] = bfhi(bv.y); Bs[lk + 4][lr] = bflo(bv.z); Bs[lk + 5][lr] = bfhi(bv.z); Bs[lk + 6][lr] = bflo(bv.w); Bs[lk + 7][lr] = bfhi(bv.w);
        __syncthreads();
#pragma unroll 8
        for (int kk = 0; kk < 32; ++kk) {
            const float a0 = As[kk][2 * ty], a1 = As[kk][2 * ty + 1];
            const f32x4 b0 = *(const f32x4*)&Bs[kk][8 * tx], b1 = *(const f32x4*)&Bs[kk][8 * tx + 4];
#pragma unroll
            for (int j = 0; j < 4; ++j) { acc[0][j] += a0 * b0[j]; acc[0][4 + j] += a0 * b1[j]; acc[1][j] += a1 * b0[j]; acc[1][4 + j] += a1 * b1[j]; }
        }
    }
    E.store8(m0 + 2 * ty, n0 + 8 * tx, acc[0]); E.store8(m0 + 2 * ty + 1, n0 + 8 * tx, acc[1]);
}

__global__ __launch_bounds__(128) void ref_attn(Args a, int li) {
    __shared__ float qs[128]; __shared__ float sc[768]; __shared__ float red[4];
    const bf16* QK = (const bf16*)(a.ws + WS_QK); const bf16* VT = (const bf16*)(a.ws + WS_VT); const bf16* CK = (const bf16*)(a.ws + WS_CK); const bf16* CVT = (const bf16*)(a.ws + WS_CVT);
    bf16* AO = (bf16*)(a.ws + WS_AO);
    const int tok = blockIdx.x >> 4, h = blockIdx.x & 15, tid = threadIdx.x;
    qs[tid] = bf2f(QK[((size_t)h * T + tok) * 128 + tid]);
    __syncthreads();
    const bool lat = tok >= T_P; const int nkeys = lat ? 768 : 256;
    const int bs = lat ? (tok - T_P) >> 10 : 0, tt = (tok - T_P) & 1023, r = tt >> 6, cq = tt & 63, row_start = clampi(r - 4, 0, 8), col_start = clampi(cq - 8, 0, 48);
    const float scale = 0.08838834764831845f;
    float lmax = -3.0e38f;
    for (int key = tid; key < nkeys; key += 128) {
        const bf16* kp; bool valid = true; float bias = 0.f;
        if (!lat) kp = QK + (size_t)T * 2048 + ((size_t)h * T + (tok & ~255) + key) * 128;
        else if (key < 512) { const int kri = key >> 6, ck = key & 63, krow = row_start + kri;
            kp = QK + (size_t)T * 2048 + ((size_t)h * T + T_P + bs * 1024 + krow * 64 + ck) * 128;
            valid = ck >= col_start && ck < col_start + 16;
            const int dr = krow - r + 7, dc = clampi(ck - cq + 15, 0, 30);
            bias = a.in[IN_RPB][(((size_t)li * 16 + h) * 15 + dr) * 31 + dc];
        } else kp = CK + ((((size_t)bs * 2 + li) * 16 + h) * 256 + (key - 512)) * 128;
        float s = 0.f;
        for (int d = 0; d < 128; ++d) s += qs[d] * bf2f(kp[d]);
        s = valid ? s * scale + bias : -1e30f;
        sc[key] = s; lmax = fmaxf(lmax, s);
    }
    for (int o = 32; o >= 1; o >>= 1) lmax = fmaxf(lmax, __shfl_xor(lmax, o));
    if ((tid & 63) == 0) red[tid >> 6] = lmax;
    __syncthreads();
    const float mx = fmaxf(red[0], red[1]);
    float lsum = 0.f;
    for (int key = tid; key < nkeys; key += 128) { const float p = __expf(sc[key] - mx); sc[key] = p; lsum += p; }
    for (int o = 32; o >= 1; o >>= 1) lsum += __shfl_xor(lsum, o);
    if ((tid & 63) == 0) red[2 + (tid >> 6)] = lsum;
    __syncthreads();
    const float inv = 1.f / (red[2] + red[3]);
    float o = 0.f; const int d = tid;
    if (!lat) { const bf16* vp = VT + (size_t)(h * 128 + d) * VTP + (tok & ~255); for (int key = 0; key < 256; ++key) o += sc[key] * bf2f(vp[key]); }
    else {
        const bf16* vp = VT + (size_t)(h * 128 + d) * VTP + T_P + bs * 1024 + row_start * 64; for (int key = 0; key < 512; ++key) o += sc[key] * bf2f(vp[key]);
        const bf16* cp = CVT + ((((size_t)bs * 2 + li) * 16 + h) * 128 + d) * 256; for (int key = 0; key < 256; ++key) o += sc[512 + key] * bf2f(cp[key]);
    }
    AO[(size_t)tok * D + h * 128 + d] = (bf16)f2bf(o * inv);
}

__device__ __forceinline__ float rope_dim(const bf16* xp, int j, int pos_r, int pos_c) {
    const int half = j >> 7, second = (j >> 6) & 1, i = j & 63;
    const float x1 = bf2f(xp[half * 128 + i]), x2 = bf2f(xp[half * 128 + 64 + i]);
    const float freq = exp2f(-(float)i * (13.287712379549449f / 64.f));
    const float ang = (float)(half ? pos_c : pos_r) * freq;
    float rev = ang * 0.15915494309189535f; rev -= floorf(rev);
    const float sn = __builtin_amdgcn_sinf(rev), cs = __builtin_amdgcn_cosf(rev);
    return second ? (x1 * sn + x2 * cs) : (x1 * cs - x2 * sn);
}
__global__ __launch_bounds__(256) void ref_gla(Args a, int li) {
    __shared__ float red[4][8];
    const bf16* QK = (const bf16*)(a.ws + WS_QK); const bf16* VT = (const bf16*)(a.ws + WS_VT); const float* TLR = (const float*)(a.ws + WS_TLR); float* OG = (float*)(a.ws + WS_OG);
    int u = blockIdx.x; const int dvg = u & 63; u >>= 6; const int dir = u & 1; u >>= 1; const int hh = u & 3; const int seq = u >> 2;
    const int j = threadIdx.x, lane = j & 63, wv = j >> 6;
    const bool lat = seq >= 16; const int tb = lat ? T_P + (seq - 16) * 1024 : seq * 256, L = lat ? 1024 : 256, dv0 = dvg * 8;
    float S[8];
#pragma unroll
    for (int e = 0; e < 8; ++e) S[e] = lat ? a.in[IN_SG][(((((size_t)(seq - 16) * 2 + li) * 2 + dir) * 4 + hh) * 256 + j) * 512 + dv0 + e] : 0.f;
    float w2[16];
#pragma unroll
    for (int r = 0; r < 16; ++r) w2[r] = a.in[IN_WA2][(((size_t)li * 2 + dir) * 16 + r) * 1024 + hh * 256 + j];
    const float bz = a.in[IN_BA][((size_t)li * 2 + dir) * 1024 + hh * 256 + j];
    for (int p = 0; p < L; ++p) {
        const int to = dir ? L - 1 - p : p, tok = tb + to;
        float z = bz;
#pragma unroll
        for (int r = 0; r < 16; ++r) z += TLR[(size_t)tok * 32 + dir * 16 + r] * w2[r];
        const float dec = __expf(logsigmoid_f(z) * (1.f / 16.f));
        float qv, kv;
        const bf16* qp = QK + (size_t)tok * 4096 + hh * 256; const bf16* kp = qp + 1024;
        if (lat) { qv = rope_dim(qp, j, to >> 6, to & 63); kv = rope_dim(kp, j, to >> 6, to & 63); } else { qv = bf2f(qp[j]); kv = bf2f(kp[j]); }
        qv *= 0.0625f;
        float pr[8];
#pragma unroll
        for (int e = 0; e < 8; ++e) { const float v = bf2f(VT[(size_t)(hh * 512 + dv0 + e) * VTP + tok]); S[e] = dec * S[e] + kv * v; pr[e] = qv * S[e]; }
#pragma unroll
        for (int e = 0; e < 8; ++e) { float s = pr[e]; for (int o = 32; o >= 1; o >>= 1) s += __shfl_xor(s, o); pr[e] = s; }
        __syncthreads();
        if (lane == 0) {
#pragma unroll
            for (int e = 0; e < 8; ++e) red[wv][e] = pr[e]; }
        __syncthreads();
        if (j < 8) OG[(size_t)dir * T * D + (size_t)tok * D + hh * 512 + dv0 + j] = (red[0][j] + red[1][j]) + (red[2][j] + red[3][j]);
    }
    if (!lat) {
#pragma unroll
        for (int e = 0; e < 8; ++e) a.out[OUT_GLA + (((((size_t)seq * 2 + li) * 2 + dir) * 4 + hh) * 256 + j) * 512 + dv0 + e] = S[e];
    }
}

#define MFMA16(a, b, c) __builtin_amdgcn_mfma_f32_16x16x32_bf16((a), (b), (c), 0, 0, 0)
struct AttState { f32x4 o[8]; float m, l; };

struct AttFrags { bf16x8 kf[2][4]; bf16x8 vf[8]; };
constexpr int AT_KP = 136, AT_VP = 72, AT_KB = 64 * AT_KP * 2  , AT_VB = 128 * AT_VP * 2  , AT_STAGE = AT_KB + AT_VB  , AT_RP = 2 * AT_STAGE  ;
struct AttSrc { const bf16* kb; const bf16* vb; int vstride; };

__device__ __forceinline__ void attn_half(AttState& st, const bf16x8 (&qf)[4], LAS unsigned char* lds, unsigned kfo, unsigned vfo, int kg, int lat, int rprow, int ck0, int qcol, int col_start) {
    const float SC = 0.08838834764831845f * LOG2E;
    AttFrags f;
#pragma unroll
    for (int s = 0; s < 2; ++s)
#pragma unroll
        for (int c = 0; c < 4; ++c) f.kf[s][c] = *(const LAS bf16x8*)(lds + kfo + s * (4 * AT_KP * 2) + c * 64);
#pragma unroll
    for (int dt = 0; dt < 8; ++dt) f.vf[dt] = *(const LAS bf16x8*)(lds + vfo + dt * (16 * AT_VP * 2));
    f32x4 sa[2];
#pragma unroll
    for (int s = 0; s < 2; ++s) { f32x4 acc = {0.f, 0.f, 0.f, 0.f};
#pragma unroll
        for (int c = 0; c < 4; ++c) acc = MFMA16(f.kf[s][c], qf[c], acc);
        sa[s] = acc; }
    const LAS float* rp = (const LAS float*)(lds + AT_RP);
    float mx = -1e30f; float v[8];
#pragma unroll
    for (int e = 0; e < 8; ++e) { const int ck = ck0 + 8 * kg + e; const bool valid = !lat || (ck >= col_start && ck < col_start + 16);
        const float b = lat ? rp[rprow * 32 + clampi(ck - qcol + 15, 0, 30)] * LOG2E : 0.f;
        v[e] = valid ? sa[e >> 2][e & 3] * SC + b : -1e30f; mx = fmaxf(mx, v[e]); }
    mx = fmaxf(mx, __shfl_xor(mx, 16)); mx = fmaxf(mx, __shfl_xor(mx, 32));
    const float mn = fmaxf(st.m, mx), alpha = __builtin_amdgcn_exp2f(st.m - mn);
    float ps = 0.f; float p[8];
#pragma unroll
    for (int e = 0; e < 8; ++e) { const float ex = __builtin_amdgcn_exp2f(v[e] - mn); p[e] = v[e] > -1e29f ? ex : 0.f; ps += p[e]; }
    u32x4 w; w.x = cvtpk(p[0], p[1]); w.y = cvtpk(p[2], p[3]); w.z = cvtpk(p[4], p[5]); w.w = cvtpk(p[6], p[7]);
    const bf16x8 pf = __builtin_bit_cast(bf16x8, w);
    ps += __shfl_xor(ps, 16); ps += __shfl_xor(ps, 32);
    st.l = st.l * alpha + ps; st.m = mn;
#pragma unroll
    for (int dt = 0; dt < 8; ++dt) st.o[dt] = MFMA16(f.vf[dt], pf, st.o[dt] * alpha);
}

__device__ __forceinline__ void attn_phase(const Args& a, LAS unsigned char* lds, int bid, int G, int tid, int li, int ulo = 0, int uhi = 768) {
    const bf16* QK = (const bf16*)(a.ws + WS_QK); const bf16* VT = (const bf16*)(a.ws + WS_VT); const bf16* CK = (const bf16*)(a.ws + WS_CK); const bf16* CVT = (const bf16*)(a.ws + WS_CVT);
    const bf16* KH = QK + (size_t)T * 2048;
    bf16* AO = (bf16*)(a.ws + WS_AO);
    const int lane = tid & 63, wave = __builtin_amdgcn_readfirstlane(tid >> 6), ln = lane & 15, kg = lane >> 4;
    unsigned kst = (unsigned)((tid >> 4) * AT_KP * 2 + (tid & 15) * 16), vst = (unsigned)AT_KB + (unsigned)((tid >> 3) * AT_VP * 2 + (tid & 7) * 16);
    unsigned kfo = (unsigned)((8 * (ln >> 2) + (ln & 3)) * AT_KP * 2 + kg * 16), vfo = (unsigned)AT_KB + (unsigned)(ln * AT_VP * 2 + kg * 16);
    asm volatile("" : "+v"(kst), "+v"(vst), "+v"(kfo), "+v"(vfo));
    for (int u = ulo + bid; u < uhi; u += G) {
        int h, tq0;
        const bool lat = u >= 512;
        int b = 0, bs = 0, rp2 = 0;
        if (!lat) { b = u >> 5; h = (u >> 1) & 15; tq0 = b * 256 + (u & 1) * 128 + 16 * wave; }
        else { const int v = u - 512; bs = v >> 7; h = (v >> 3) & 15; rp2 = 2 * (v & 7); tq0 = T_P + bs * 1024 + (rp2 + (wave >> 2)) * 64 + 16 * (wave & 3); }
        const int r = rp2 + (wave >> 2);
        bf16x8 qf[4];
#pragma unroll
        for (int c = 0; c < 4; ++c) qf[c] = *(const bf16x8*)(QK + ((size_t)h * T + tq0 + ln) * 128 + 32 * c + 8 * kg);
        AttState st;
#pragma unroll
        for (int dt = 0; dt < 8; ++dt) st.o[dt] = (f32x4){0.f, 0.f, 0.f, 0.f};
        st.m = -1e30f; st.l = 0.f;
        const int cq = wave & 3, row_start = clampi(r - 4, 0, 8), qcol = 16 * cq + ln, col_start = clampi(qcol - 8, 0, 48);
        const int h0 = cq == 3 ? 1 : 0, h1 = cq == 0 ? 1 : 2;
        const int rs0 = clampi(rp2 - 4, 0, 8), nlat = lat ? clampi(rp2 + 1 - 4, 0, 8) + 8 - rs0 : 0, ntile = nlat + 4;
        const size_t cm = ((size_t)bs * 2 + li) * 16 + h;
        auto src_of = [&](int j) -> AttSrc {
            AttSrc t;
            if (!lat) { const int tb = b * 256 + 64 * j; t.kb = KH + ((size_t)h * T + tb) * 128; t.vb = VT + (size_t)(h * 128) * VTP + tb; t.vstride = VTP; }
            else if (j < nlat) { const int tb = T_P + bs * 1024 + (rs0 + j) * 64; t.kb = KH + ((size_t)h * T + tb) * 128; t.vb = VT + (size_t)(h * 128) * VTP + tb; t.vstride = VTP; }
            else { const int kt = j - nlat; t.kb = CK + (cm * 256 + 64 * kt) * 128; t.vb = CVT + cm * 128 * 256 + 64 * kt; t.vstride = 256; }
            return t;
        };
        u32x4 sk[2], sv[2];
        auto stage_load = [&](int j) { const AttSrc t = src_of(j);
#pragma unroll
            for (int q = 0; q < 2; ++q) { sk[q] = *(const u32x4*)((const char*)t.kb + (size_t)(tid + 512 * q) * 16);
                sv[q] = *(const u32x4*)((const char*)t.vb + ((size_t)((tid >> 3) + 64 * q) * t.vstride) * 2 + (tid & 7) * 16); } };
        auto stage_store = [&](int buf) {
#pragma unroll
            for (int q = 0; q < 2; ++q) { *(LAS u32x4*)(lds + buf * AT_STAGE + kst + q * (32 * AT_KP * 2)) = sk[q]; *(LAS u32x4*)(lds + buf * AT_STAGE + vst + q * (64 * AT_VP * 2)) = sv[q]; } };
        __syncthreads();
        if (lat && tid < 15 * 31) { const int dr = tid / 31, dc = tid - dr * 31; ((LAS float*)(lds + AT_RP))[dr * 32 + dc] = a.in[IN_RPB][((size_t)li * 16 + h) * 15 * 31 + tid]; }
        stage_load(0); stage_store(0);
        __syncthreads();
#pragma unroll 1
        for (int j = 0; j < ntile; ++j) {
            const int buf = j & 1;
            if (j + 1 < ntile) stage_load(j + 1);
            const bool islat = lat && j < nlat; const int krow = rs0 + j;
            const bool act = !islat || (krow >= row_start && krow < row_start + 8);
            if (act) {
                const int f0 = islat ? h0 : 0, f1 = islat ? h1 : 2;
                for (int hf = f0; hf < f1; ++hf)
                    attn_half(st, qf, lds, buf * AT_STAGE + kfo + hf * (32 * AT_KP * 2), buf * AT_STAGE + vfo + hf * 64, kg, islat, krow - r + 7, 32 * hf, qcol, col_start);
            }
            if (j + 1 < ntile) stage_store(buf ^ 1);
            __syncthreads();
        }
        const float inv = 1.f / st.l;
        bf16* op = AO + (size_t)(tq0 + ln) * D + h * 128 + 4 * kg;
#pragma unroll
        for (int dt = 0; dt < 8; ++dt) { const f32x4 o = st.o[dt] * inv; u32x2 w; w.x = cvtpk(o[0], o[1]); w.y = cvtpk(o[2], o[3]); *(u32x2*)(op + 16 * dt) = w; }
    }
}

constexpr int GL_QD = 0, GL_KLT = 33792, GL_P = 70656, GL_DEC = 79872, GL_IMG = 80896, GL_KD = 80896, GL_GT = 114688;
constexpr int GL_QS = 264, GL_KLS = 72, GL_PS = 72;
constexpr size_t WS_GIMG = WS_HID;
#define LDSP(T_, off) ((LAS T_*)(lds + (off)))
__device__ __forceinline__ int gla_img_index(int seq, int nc, int hh, int dir) { const int cb = seq < 16 ? 4 * seq : 64 + 16 * (seq - 16); return ((cb + nc) * 4 + hh) * 2 + dir; }

__device__ __forceinline__ void gla_prep_unit(const Args& a, LAS unsigned char* lds, int tid, int li, int seq, int nc, int hh, int dir) {
    const bf16* QK = (const bf16*)(a.ws + WS_QK); const float* TLR = (const float*)(a.ws + WS_TLR);
    const int lane = tid & 63, wave = __builtin_amdgcn_readfirstlane(tid >> 6), ln = lane & 15, kg = lane >> 4;
    const bool lat = seq >= 16;
    const int tok0 = (lat ? T_P + (seq - 16) * 1024 : seq * 256) + nc * 64;
    const int half = lane >> 5, i0 = 2 * (lane & 31), ca = half * 128 + i0;
    unsigned la_w = (unsigned)(8 * wave * GL_QS + ca) * 2u;
    unsigned la_klt = (unsigned)GL_KLT + (unsigned)(ca * GL_KLS + 8 * wave) * 2u;
    unsigned la_gt = (unsigned)GL_GT + (unsigned)ca * 4u;
    unsigned la_dec = (unsigned)GL_DEC + (unsigned)ca * 4u;
    unsigned la_fr = (unsigned)(ln * GL_QS + 8 * kg) * 2u;
    unsigned la_pw = (unsigned)GL_P + (unsigned)(ln * GL_PS + 4 * kg) * 2u;
    asm volatile("" : "+v"(la_w), "+v"(la_klt), "+v"(la_gt), "+v"(la_dec), "+v"(la_fr), "+v"(la_pw));
    const float* w2p = a.in[IN_WA2] + ((size_t)li * 2 + dir) * 16 * 1024 + hh * 256 + ca;
    const float* bap = a.in[IN_BA] + ((size_t)li * 2 + dir) * 1024 + hh * 256 + ca;
    const float bz0 = bap[0], bz1 = bap[1], bz2 = bap[64], bz3 = bap[65];
    const float fr0 = exp2f(-(float)i0 * (13.287712379549449f / 64.f)), fr1 = exp2f(-(float)(i0 + 1) * (13.287712379549449f / 64.f));
    float cum[8][4];
    {
#pragma unroll
        for (int t = 0; t < 8; ++t) { cum[t][0] = bz0; cum[t][1] = bz1; cum[t][2] = bz2; cum[t][3] = bz3; }
        const float* wp = w2p; const float* tp = TLR + (size_t)(tok0 + 8 * wave) * 32 + dir * 16;
#pragma unroll 1
        for (int r4 = 0; r4 < 4; ++r4, tp += 4) {
            f32x2 wa[4], wb[4];
#pragma unroll
            for (int rr = 0; rr < 4; ++rr, wp += 1024) { wa[rr] = *(const f32x2*)wp; wb[rr] = *(const f32x2*)(wp + 64); }
#pragma unroll
            for (int t = 0; t < 8; ++t) { const f32x4 tl = *(const f32x4*)(tp + t * 32);
#pragma unroll
                for (int rr = 0; rr < 4; ++rr) { cum[t][0] += tl[rr] * wa[rr][0]; cum[t][1] += tl[rr] * wa[rr][1]; cum[t][2] += tl[rr] * wb[rr][0]; cum[t][3] += tl[rr] * wb[rr][1]; } }
        }
        float run[4] = {0.f, 0.f, 0.f, 0.f};
        if (dir == 0) {
#pragma unroll
            for (int t = 0; t < 8; ++t)
#pragma unroll
                for (int e = 0; e < 4; ++e) { run[e] += logsigmoid_f(cum[t][e]) * (1.f / 16.f); cum[t][e] = run[e]; }
        } else {
#pragma unroll
            for (int t = 7; t >= 0; --t)
#pragma unroll
                for (int e = 0; e < 4; ++e) { run[e] += logsigmoid_f(cum[t][e]) * (1.f / 16.f); cum[t][e] = run[e]; }
        }
        *LDSP(f32x2, la_gt + wave * 1024) = (f32x2){run[0], run[1]}; *LDSP(f32x2, la_gt + wave * 1024 + 256) = (f32x2){run[2], run[3]};
    }
    __syncthreads();
    {
        float pre[4] = {0.f, 0.f, 0.f, 0.f}, tot[4] = {0.f, 0.f, 0.f, 0.f};
#pragma unroll
        for (int g = 0; g < 8; ++g) { const f32x2 x = *LDSP(f32x2, la_gt + g * 1024), y = *LDSP(f32x2, la_gt + g * 1024 + 256);
            const bool before = dir ? (g > wave) : (g < wave);
            tot[0] += x[0]; tot[1] += x[1]; tot[2] += y[0]; tot[3] += y[1];
            if (before) { pre[0] += x[0]; pre[1] += x[1]; pre[2] += y[0]; pre[3] += y[1]; } }
        float dtot[4];
#pragma unroll
        for (int e = 0; e < 4; ++e) dtot[e] = __expf(tot[e]);
        if (wave == 0) { *LDSP(f32x2, la_dec) = (f32x2){dtot[0], dtot[1]}; *LDSP(f32x2, la_dec + 256) = (f32x2){dtot[2], dtot[3]}; }
        unsigned klp[4][4];
        float klh[4] = {0.f, 0.f, 0.f, 0.f};
        const bf16* qp = QK + (size_t)(tok0 + 8 * wave) * 4096 + hh * 256 + ca;
#pragma unroll
        for (int t = 0; t < 8; ++t, qp += 4096) {
            const unsigned qa = *(const unsigned*)(qp), qb = *(const unsigned*)(qp + 64), ka = *(const unsigned*)(qp + 1024), kb2 = *(const unsigned*)(qp + 1024 + 64);
            float q[4] = {bflo(qa), bfhi(qa), bflo(qb), bfhi(qb)}, k[4] = {bflo(ka), bfhi(ka), bflo(kb2), bfhi(kb2)};
            if (lat) {
                const float pos = (float)(half ? 8 * wave + t : nc);
                float r0 = pos * fr0 * 0.15915494309189535f, r1 = pos * fr1 * 0.15915494309189535f; r0 -= floorf(r0); r1 -= floorf(r1);
                const float s0 = __builtin_amdgcn_sinf(r0), c0 = __builtin_amdgcn_cosf(r0), s1 = __builtin_amdgcn_sinf(r1), c1 = __builtin_amdgcn_cosf(r1);
                const float q0 = q[0] * c0 - q[2] * s0, q2 = q[0] * s0 + q[2] * c0, q1 = q[1] * c1 - q[3] * s1, q3 = q[1] * s1 + q[3] * c1;
                const float k0 = k[0] * c0 - k[2] * s0, k2 = k[0] * s0 + k[2] * c0, k1 = k[1] * c1 - k[3] * s1, k3 = k[1] * s1 + k[3] * c1;
                q[0] = q0; q[1] = q1; q[2] = q2; q[3] = q3; k[0] = k0; k[1] = k1; k[2] = k2; k[3] = k3;
            }
            float qd[4], kd[4];
#pragma unroll
            for (int e = 0; e < 4; ++e) { const float cm = pre[e] + cum[t][e], ec = __expf(cm), ei = __builtin_amdgcn_rcpf(ec); qd[e] = q[e] * 0.0625f * ec; kd[e] = k[e] * ei;
                const float kl = kd[e] * dtot[e]; if (t & 1) klp[e][t >> 1] = cvtpk(klh[e], kl); else klh[e] = kl; }
            *LDSP(unsigned, GL_QD + la_w + t * (GL_QS * 2)) = cvtpk(qd[0], qd[1]); *LDSP(unsigned, GL_QD + la_w + t * (GL_QS * 2) + 128) = cvtpk(qd[2], qd[3]);
            *LDSP(unsigned, GL_KD + la_w + t * (GL_QS * 2)) = cvtpk(kd[0], kd[1]); *LDSP(unsigned, GL_KD + la_w + t * (GL_QS * 2) + 128) = cvtpk(kd[2], kd[3]);
        }
#pragma unroll
        for (int e = 0; e < 4; ++e) { const int coff = ((e < 2 ? 0 : 64) + (e & 1)) * GL_KLS * 2;
            u32x4 w; w.x = klp[e][0]; w.y = klp[e][1]; w.z = klp[e][2]; w.w = klp[e][3];
            *LDSP(u32x4, la_klt + coff) = w; }
    }
    __syncthreads();
#pragma unroll
    for (int j = 0; j < 2; ++j) { const int idx = 2 * wave + j, sb = idx >> 2, tbk = idx & 3;
        f32x4 acc = {0.f, 0.f, 0.f, 0.f};
        const unsigned ka_ = GL_KD + la_fr + sb * (16 * GL_QS * 2), qa_ = GL_QD + la_fr + tbk * (16 * GL_QS * 2);
#pragma unroll
        for (int c = 0; c < 8; ++c) { const bf16x8 af = *LDSP(const bf16x8, ka_ + 64 * c), bfr = *LDSP(const bf16x8, qa_ + 64 * c); acc = MFMA16(af, bfr, acc); }
        const int t = 16 * tbk + ln;
        float pv[4];
#pragma unroll
        for (int i = 0; i < 4; ++i) { const int s = 16 * sb + 4 * kg + i; const bool keep = dir ? (s >= t) : (s <= t); pv[i] = keep ? acc[i] : 0.f; }
        u32x2 w; w.x = cvtpk(pv[0], pv[1]); w.y = cvtpk(pv[2], pv[3]);
        *LDSP(u32x2, la_pw + tbk * (16 * GL_PS * 2) + sb * 32) = w; }
    __syncthreads();
    {
        unsigned char* img = a.ws + WS_GIMG + (size_t)gla_img_index(seq, nc, hh, dir) * GL_IMG;
#pragma unroll
        for (int j = 0; j < 10; ++j) { const int pc = tid + 512 * j; if (pc < GL_IMG / 16) *(u32x4*)(img + (size_t)pc * 16) = *LDSP(const u32x4, pc * 16); }
    }
    __syncthreads();
}

__device__ __forceinline__ void gla_prep_phase(const Args& a, LAS unsigned char* lds, int bid, int G, int tid, int li) {
    for (int u = bid; u < 768; u += G) { const int dir = u & 1, hh = (u >> 1) & 3, cpos = u >> 3;
        const int seq = cpos < 64 ? cpos >> 2 : 16 + ((cpos - 64) >> 4), nc = cpos < 64 ? cpos & 3 : (cpos - 64) & 15;
        gla_prep_unit(a, lds, tid, li, seq, nc, hh, dir); }
}

__device__ __forceinline__ void gla_scan_unit(const Args& a, LAS unsigned char* lds, int tid, int li, int seq, int hh, int dir, int dvs) {
    const bf16* VT = (const bf16*)(a.ws + WS_VT); float* OG = (float*)(a.ws + WS_OG);
    const int lane = tid & 63, wave = __builtin_amdgcn_readfirstlane(tid >> 6), ln = lane & 15, kg = lane >> 4;
    const bool lat = seq >= 16;
    const int tb = lat ? T_P + (seq - 16) * 1024 : seq * 256, nch = lat ? 16 : 4;
    unsigned la_fr = (unsigned)GL_QD + (unsigned)(ln * GL_QS + 8 * kg) * 2u;
    unsigned la_p = (unsigned)GL_P + (unsigned)(ln * GL_PS + 8 * kg) * 2u;
    unsigned la_kr = (unsigned)GL_KLT + (unsigned)((8 * (ln >> 2) + (ln & 3)) * GL_KLS + 8 * kg) * 2u;
    unsigned la_dr = (unsigned)GL_DEC + (unsigned)(8 * kg) * 4u;
    unsigned la_cp = (unsigned)tid * 16u;
    asm volatile("" : "+v"(la_fr), "+v"(la_p), "+v"(la_kr), "+v"(la_dr), "+v"(la_cp));
    const int dvcol = dvs * 128 + 16 * wave + ln;
    f32x4 Sacc[8][2];
    if (lat) { const float* sp = a.in[IN_SG] + ((((size_t)(seq - 16) * 2 + li) * 2 + dir) * 4 + hh) * 256 * 512 + dvcol + (size_t)(8 * kg) * 512;
#pragma unroll
        for (int c = 0; c < 8; ++c)
#pragma unroll
            for (int s = 0; s < 2; ++s)
#pragma unroll
                for (int i = 0; i < 4; ++i) Sacc[c][s][i] = sp[(size_t)(32 * c + 4 * s + i) * 512];
    } else {
#pragma unroll
        for (int c = 0; c < 8; ++c)
#pragma unroll
            for (int s = 0; s < 2; ++s) Sacc[c][s] = (f32x4){0.f, 0.f, 0.f, 0.f};
    }
    const bf16* vrow = VT + (size_t)(hh * 512 + dvcol) * VTP + 8 * kg;
    const unsigned char* imgs = a.ws + WS_GIMG;
    u32x4 stg[10]; bf16x8 vfn[2];
    { const int nc = dir ? nch - 1 : 0; const unsigned char* img = imgs + (size_t)gla_img_index(seq, nc, hh, dir) * GL_IMG + la_cp;
#pragma unroll
      for (int j = 0; j < 10; ++j) if (j < 9 || tid < (GL_IMG / 16 - 9 * 512)) stg[j] = *(const u32x4*)(img + (size_t)j * 8192);
#pragma unroll
      for (int c = 0; c < 2; ++c) vfn[c] = *(const bf16x8*)(vrow + tb + nc * 64 + 32 * c); }
#pragma unroll 1
    for (int p = 0; p < nch; ++p) {
        const int nc = dir ? nch - 1 - p : p, tok0 = tb + nc * 64;
#pragma unroll
        for (int j = 0; j < 10; ++j) if (j < 9 || tid < (GL_IMG / 16 - 9 * 512)) *LDSP(u32x4, la_cp + j * 8192) = stg[j];
        bf16x8 vf[2] = {vfn[0], vfn[1]};
        __syncthreads();
        if (p + 1 < nch) { const int nn = dir ? nch - 2 - p : p + 1; const unsigned char* img = imgs + (size_t)gla_img_index(seq, nn, hh, dir) * GL_IMG + la_cp;
#pragma unroll
            for (int j = 0; j < 10; ++j) if (j < 9 || tid < (GL_IMG / 16 - 9 * 512)) stg[j] = *(const u32x4*)(img + (size_t)j * 8192);
#pragma unroll
            for (int c = 0; c < 2; ++c) vfn[c] = *(const bf16x8*)(vrow + tb + nn * 64 + 32 * c); }
        {
            bf16x8 sf[8];
#pragma unroll
            for (int c = 0; c < 8; ++c) { u32x4 w; w.x = cvtpk(Sacc[c][0][0], Sacc[c][0][1]); w.y = cvtpk(Sacc[c][0][2], Sacc[c][0][3]); w.z = cvtpk(Sacc[c][1][0], Sacc[c][1][1]); w.w = cvtpk(Sacc[c][1][2], Sacc[c][1][3]);
                sf[c] = __builtin_bit_cast(bf16x8, w); }
            const size_t ogi = (size_t)dir * T * D + (size_t)(tok0 + ln) * D + hh * 512 + dvs * 128 + 16 * wave + 4 * kg;
#pragma unroll
            for (int tt = 0; tt < 4; ++tt) {
                f32x4 o = {0.f, 0.f, 0.f, 0.f};
#pragma unroll
                for (int c = 0; c < 2; ++c) { const bf16x8 pf = *LDSP(const bf16x8, la_p + tt * (16 * GL_PS * 2) + 64 * c); o = MFMA16(vf[c], pf, o); }
#pragma unroll
                for (int c = 0; c < 8; ++c) { const bf16x8 qf = *LDSP(const bf16x8, la_fr + tt * (16 * GL_QS * 2) + 64 * c); o = MFMA16(sf[c], qf, o); }
                if (OG_BF16) { u32x2 w; w.x = cvtpk(o[0], o[1]); w.y = cvtpk(o[2], o[3]); *(u32x2*)((bf16*)OG + ogi + (size_t)(16 * tt) * D) = w; }
                else *(f32x4*)(OG + ogi + (size_t)(16 * tt) * D) = o;
            }
#pragma unroll
            for (int c = 0; c < 8; ++c)
#pragma unroll
                for (int s = 0; s < 2; ++s) {
                    const f32x4 dc = *LDSP(const f32x4, la_dr + (32 * c + 4 * s) * 4);
                    f32x4 acc = Sacc[c][s] * dc;
#pragma unroll
                    for (int c2 = 0; c2 < 2; ++c2) { const bf16x8 kf = *LDSP(const bf16x8, la_kr + (32 * c + 4 * s) * (GL_KLS * 2) + 64 * c2); acc = MFMA16(kf, vf[c2], acc); }
                    Sacc[c][s] = acc;
                }
        }
        __syncthreads();
    }
    if (!lat) { float* sp = a.out + OUT_GLA + ((((size_t)seq * 2 + li) * 2 + dir) * 4 + hh) * 256 * 512 + dvcol + (size_t)(8 * kg) * 512;
#pragma unroll
        for (int c = 0; c < 8; ++c)
#pragma unroll
            for (int s = 0; s < 2; ++s)
#pragma unroll
                for (int i = 0; i < 4; ++i) sp[(size_t)(32 * c + 4 * s + i) * 512] = Sacc[c][s][i];
    }
}

__device__ __forceinline__ void gla_scan_phase(const Args& a, LAS unsigned char* lds, int bid, int G, int tid, int li) {
    if (G > 64) {
        if (bid < 64) { const int u = bid; gla_scan_unit(a, lds, tid, li, 16 + (u >> 5), (u >> 3) & 3, (u >> 2) & 1, u & 3); }
        else for (int u = bid - 64; u < 512; u += G - 64) gla_scan_unit(a, lds, tid, li, u >> 5, (u >> 3) & 3, (u >> 2) & 1, u & 3);
    } else {
        for (int u = bid; u < 576; u += G) gla_scan_unit(a, lds, tid, li, u >> 5, (u >> 3) & 3, (u >> 2) & 1, u & 3);
    }
}
#undef LDSP

#ifndef PROBE_DOUBLE
#define PROBE_DOUBLE 0
#endif
#ifndef STAGGER
#define STAGGER 0
#endif
#ifndef W2_SPLITK
#define W2_SPLITK 0
#endif
constexpr int LDS_BYTES = 147456;
constexpr int MISC_OFF = 131072 + 320;

__global__ void __launch_bounds__(512, 2) mega_fwd(Args a) {
    extern __shared__ __attribute__((aligned(16))) unsigned char lds_raw[];
    LAS unsigned char* lds = (LAS unsigned char*)lds_raw;
    volatile LAS unsigned* MISC = (volatile LAS unsigned*)(lds + MISC_OFF);
    const int G = gridDim.x, bid = blockIdx.x;
    for (int u = threadIdx.x; u < (LDS_BYTES - 131072) / 4; u += 512) ((LAS unsigned*)(lds + 131072))[u] = 0u;
    __syncthreads();
    unsigned* ctl = (unsigned*)(a.ws + WS_CTL);
    const int lo = a.ph_lo, hi = a.ph_hi;
    XcdBarrier bar = xcd_barrier_post(ctl + CW_BAR + lo * XCD_BAR_WORDS, MISC + 8);
#define IN(k) (lo <= (k) && (k) < hi)
#define SEAM(k) do { if (IN(k) && IN((k) + 1)) { xcd_barrier(bar); if (PROBE_DOUBLE & 16) xcd_barrier(bar); } } while (0)
    const int ngw = G * 8;
#define LANEVARS int tid = threadIdx.x; asm volatile("" : "+v"(tid)); const int lane = tid & 63, wave = __builtin_amdgcn_readfirstlane(tid >> 6), gw = bid * 8 + wave; (void)lane; (void)gw
    unsigned char* ws = a.ws;
    const float* MOD = (const float*)(ws + WS_MOD);
    const float* NG = a.in[IN_NORMG];
    bf16* H = (bf16*)(ws + WS_H); bf16* QK = (bf16*)(ws + WS_QK); bf16* VT = (bf16*)(ws + WS_VT); bf16* AO = (bf16*)(ws + WS_AO); bf16* HID = (bf16*)(ws + WS_HID);
    float* Y = (float*)(ws + WS_Y); float* TLR = (float*)(ws + WS_TLR);

    if (IN(PH_PRO)) { LANEVARS; prologue_phase(a, lds, bid, G, tid); if (PROBE_DOUBLE & 8) { __syncthreads(); prologue_phase(a, lds, bid, G, tid); } }
    SEAM(PH_PRO);
    if (IN(PH_R0)) { LANEVARS; row_phase<true, false, true>(a, gw, ngw, lane, nullptr, nullptr, 0, NG + 0 * D, MOD, 0, 1); }
    SEAM(PH_R0);

    for (int l = 0; l < NL; ++l) {
        const int pb = PH_L0 + l * PH_PER_LAYER, li = l >> 1;
        const bool gla = l & 1;
        const bf16* Wmix = (const bf16*)(ws + WS_WMIX) + (size_t)l * NMIX * D;
        const float* MODl = MOD + (size_t)l * 3 * 12288;
        for (int rep = 0; rep < ((PROBE_DOUBLE & (1 | 2048)) ? 2 : 1); ++rep)
        if (IN(pb + LP_MIX)) {
            if (!gla) {
                { pg8::Gemm g{H, Wmix, T, NQK_NA, D}; pg8::StaticOrder S; S.init(T, NQK_NA, G, bid);
                  EpiWrap<E8NaQK> E{{QK, a.out + OUT_NK, li}}; pg8::gemm_phase<EpiWrap<E8NaQK>, pg8::StaticOrder, false, true>(lds, g, S, E); }
                { pg8::Gemm g{Wmix + (size_t)NQK_NA * D, H, 2048, T, D}; pg8::StaticOrder S; S.init(2048, T, G, (bid + 128) % G);
                  EpiWrap<E8VT> E{{VT, a.out + OUT_NV, li}}; pg8::gemm_phase<EpiWrap<E8VT>, pg8::StaticOrder, false, true>(lds, g, S, E); }
            } else {
                { pg8::Gemm g{H, Wmix, T, NQK_GLA, D}; pg8::StaticOrder S; S.init(T, NQK_GLA, G, bid);
                  EpiWrap<E8GlaQKG> E{{QK, TLR}}; pg8::gemm_phase<EpiWrap<E8GlaQKG>, pg8::StaticOrder, false, true>(lds, g, S, E); }
                { pg8::Gemm g{Wmix + (size_t)NQK_GLA * D, H, 2048, T, D}; pg8::StaticOrder S; S.init(2048, T, G, (bid + 104) % G);
                  EpiWrap<E8VT> E{{VT, nullptr, 0}}; pg8::gemm_phase<EpiWrap<E8VT>, pg8::StaticOrder, false, true>(lds, g, S, E); }
            }
        }
        if (IN(pb + LP_MIX) && l + 1 < NL) {
            const int first = gla ? 88 : 64;
            if (G == 256 && bid >= first) { LANEVARS; if (ADA_DEFER) { __syncthreads(); silu_table(a, lds, tid); ada_layer(a, lds, l + 1, bid - first, G - first, tid); } convert_weights(a, lds, l + 1, 0, CV_MIX_END, bid - first, G - first, tid); }
        }
        SEAM(pb + LP_MIX);
        if (IN(pb + LP_CORE)) {
            LANEVARS; if (!gla) { attn_phase(a, lds, bid, G, tid, li); if (PROBE_DOUBLE & 2) attn_phase(a, lds, bid, G, tid, li); if (PROBE_DOUBLE & 64) attn_phase(a, lds, bid, G, tid, li, 0, 512); if (PROBE_DOUBLE & 128) attn_phase(a, lds, bid, G, tid, li, 512, 768); }
            else { gla_prep_phase(a, lds, bid, G, tid, li); if (PROBE_DOUBLE & 32) gla_prep_phase(a, lds, bid, G, tid, li);
                   xcd_barrier(bar);
                   gla_scan_phase(a, lds, bid, G, tid, li); if (PROBE_DOUBLE & 4) gla_scan_phase(a, lds, bid, G, tid, li); }
        }
        SEAM(pb + LP_CORE);
        if (gla) {
            if (IN(pb + LP_GATE)) { LANEVARS; gla_gate_phase(a, gw, ngw, lane, li); }
            SEAM(pb + LP_GATE);
        }
        for (int rep = 0; rep < ((PROBE_DOUBLE & (1 | 1024)) ? 2 : 1); ++rep)
        if (IN(pb + LP_WO)) {
            if (l + 1 < NL && G == 256 && bid >= 192) { LANEVARS; convert_weights(a, lds, l + 1, CV_MIX_END, CV_WO_END, bid - 192, G - 192, tid); }
            pg8::Gemm g{AO, (const bf16*)(ws + WS_WO) + (size_t)l * D * D, T, D, D}; pg8::StaticOrder S; S.init(T, D, G, bid);
            if (Y_BF16) { EpiWrap<E8Bf16> E{{(bf16*)Y, D}}; pg8::gemm_phase<EpiWrap<E8Bf16>, pg8::StaticOrder, false, true>(lds, g, S, E); }
            else { EpiWrap<E8F32> E{{Y, D}}; pg8::gemm_phase<EpiWrap<E8F32>, pg8::StaticOrder, false, true>(lds, g, S, E); }
        }
        SEAM(pb + LP_WO);
        if (IN(pb + LP_ROWMID)) { LANEVARS; row_phase<false, true, true>(a, gw, ngw, lane, NG + ((size_t)l * 4 + 1) * D, MODl, 2, NG + ((size_t)l * 4 + 2) * D, MODl, 3, 4); }
        SEAM(pb + LP_ROWMID);
        for (int rep = 0; rep < ((PROBE_DOUBLE & (1 | 256)) ? 2 : 1); ++rep)
        if (IN(pb + LP_W1)) {
            if (STAGGER) { const int pos = (bid >> 3) & 31; for (int i = 0; i < pos; ++i) __builtin_amdgcn_s_sleep(STAGGER); }
            pg8::Gemm g{H, (const bf16*)(ws + WS_W1) + (size_t)l * FF * D, T, FF, D}; pg8::StaticOrder S; S.init(T, FF, G, bid);
            EpiWrap<E8Relu2> E{{HID, FF}}; pg8::gemm_phase<EpiWrap<E8Relu2>, pg8::StaticOrder, false, true>(lds, g, S, E);
        }
        SEAM(pb + LP_W1);
        for (int rep = 0; rep < ((PROBE_DOUBLE & (1 | 512)) ? 2 : 1); ++rep)
        if (IN(pb + LP_W2)) {
            constexpr int W2_UNITS = (T / 256) * (D / 256);
            if (!W2_SPLITK && l + 1 < NL && G == 256 && bid >= W2_UNITS) { LANEVARS; convert_weights(a, lds, l + 1, CV_WO_END, CV_W2_END, bid - W2_UNITS, G - W2_UNITS, tid); }

            pg8::Gemm g{HID, (const bf16*)(ws + WS_W2) + (size_t)l * D * FF, T, D, FF};
            EpiF32Part E{Y, Y + (size_t)T * D};
            if (G == 256 && W2_SPLITK) { SplitKOrder S{bid}; pg8::gemm_phase<EpiF32Part, SplitKOrder, true, true>(lds, g, S, E); }
            else if (Y_BF16) { pg8::StaticOrder S; S.init(T, D, G, bid); EpiWrap<E8Bf16> E2{{(bf16*)Y, D}}; pg8::gemm_phase<EpiWrap<E8Bf16>, pg8::StaticOrder, false, true>(lds, g, S, E2); }
            else { pg8::StaticOrder S; S.init(T, D, G, bid); pg8::gemm_phase<EpiF32Part, pg8::StaticOrder, false, true>(lds, g, S, E); }
        }
        SEAM(pb + LP_W2);
        if (IN(pb + LP_ROWEND)) {
            LANEVARS;
            if (G == 256 && W2_SPLITK) {
                if (l < NL - 1) row_phase<false, true, true, true>(a, gw, ngw, lane, NG + ((size_t)l * 4 + 3) * D, MODl, 5, NG + ((size_t)(l + 1) * 4 + 0) * D, MODl + 3 * 12288, 0, 1);
                else            row_phase<false, true, false, true>(a, gw, ngw, lane, NG + ((size_t)l * 4 + 3) * D, MODl, 5, nullptr, nullptr, 0, 0);
            } else {
                if (l < NL - 1) row_phase<false, true, true>(a, gw, ngw, lane, NG + ((size_t)l * 4 + 3) * D, MODl, 5, NG + ((size_t)(l + 1) * 4 + 0) * D, MODl + 3 * 12288, 0, 1);
                else            row_phase<false, true, false>(a, gw, ngw, lane, NG + ((size_t)l * 4 + 3) * D, MODl, 5, nullptr, nullptr, 0, 0);
            }
        }
        SEAM(pb + LP_ROWEND);
    }
#undef IN
#undef SEAM
#undef LANEVARS
}

static void launch_range(const Args& base, int lo, int hi, int grid, hipStream_t stream) {
    if (lo >= hi) return;
    Args a = base; a.ph_lo = lo; a.ph_hi = hi;
    hipLaunchKernelGGL(mega_fwd, dim3(grid), dim3(512), LDS_BYTES, stream, a);
    const hipError_t le = hipPeekAtLastError();
    if (le != hipSuccess) fprintf(stderr, "kernel_launch: mega_fwd [%d,%d) failed: %s\n", lo, hi, hipGetErrorName(le));
}
template <class E8> static void launch_ref_gemm(const bf16* A, const bf16* Bt, int M, int N, int K, const E8& E, hipStream_t stream) {
    hipLaunchKernelGGL((ref_gemm<E8>), dim3(N / 64, M / 64), dim3(256), 0, stream, A, Bt, M, N, K, E);
}

extern "C" void kernel_launch(void* const* d_in, const int* in_sizes, int n_in, void* d_out, int out_size, void* d_ws, size_t ws_size, hipStream_t stream) {
    static int grid = 0;
    if (grid == 0) {
        if (n_in != 21 || (size_t)out_size != OUT_TOTAL || ws_size < WS_END) { fprintf(stderr, "kernel_launch: unexpected shapes (n_in %d out %d ws %zu)\n", n_in, out_size, ws_size); grid = -1; return; }
        int dev = 0, cus = 0, per_cu = 0;
        if (hipGetDevice(&dev) != hipSuccess || hipDeviceGetAttribute(&cus, hipDeviceAttributeMultiprocessorCount, dev) != hipSuccess) { grid = -1; return; }
        if (hipFuncSetAttribute((const void*)mega_fwd, hipFuncAttributeMaxDynamicSharedMemorySize, LDS_BYTES) != hipSuccess) { fprintf(stderr, "kernel_launch: hipFuncSetAttribute failed\n"); grid = -1; return; }
        if (hipOccupancyMaxActiveBlocksPerMultiprocessor(&per_cu, (const void*)mega_fwd, 512, LDS_BYTES) != hipSuccess || per_cu < 1) fprintf(stderr, "kernel_launch: occupancy query says %d\n", per_cu);
        (void)hipGetLastError();
        grid = cus;
    }
    if (grid < 0) return;
    (void)hipMemsetAsync((char*)d_ws + WS_CTL, 0, CTL_ZERO_BYTES, stream);
    Args a{};
    for (int i = 0; i < 21; ++i) a.in[i] = (const float*)d_in[i];
    a.out = (float*)d_out; a.ws = (unsigned char*)d_ws;
#if CFG_ONE_LAUNCH && !CFG_NAIVE_GEMM && !CFG_NAIVE_ATTN && !CFG_NAIVE_GLA
    launch_range(a, 0, NPH, grid, stream);
#else
    unsigned char* ws = (unsigned char*)d_ws;
    bf16* H = (bf16*)(ws + WS_H); bf16* QK = (bf16*)(ws + WS_QK); bf16* VT = (bf16*)(ws + WS_VT); bf16* AO = (bf16*)(ws + WS_AO); bf16* HID = (bf16*)(ws + WS_HID);
    float* Y = (float*)(ws + WS_Y); float* TLR = (float*)(ws + WS_TLR);
    launch_range(a, PH_PRO, PH_PRO + 1, grid, stream);
    launch_range(a, PH_R0, PH_R0 + 1, grid, stream);
    for (int l = 0; l < NL; ++l) {
        const int pb = PH_L0 + l * PH_PER_LAYER, li = l >> 1; const bool gla = l & 1;
        const bf16* Wmix = (const bf16*)(ws + WS_WMIX) + (size_t)l * NMIX * D;
        if (CFG_NAIVE_GEMM) {
            if (!gla) { launch_ref_gemm(H, Wmix, T, NQK_NA, D, E8NaQK{QK, a.out + OUT_NK, li}, stream); launch_ref_gemm(Wmix + (size_t)NQK_NA * D, H, 2048, T, D, E8VT{VT, a.out + OUT_NV, li}, stream); }
            else { launch_ref_gemm(H, Wmix, T, NQK_GLA, D, E8GlaQKG{QK, TLR}, stream); launch_ref_gemm(Wmix + (size_t)NQK_GLA * D, H, 2048, T, D, E8VT{VT, nullptr, 0}, stream); }
        } else launch_range(a, pb + LP_MIX, pb + LP_MIX + 1, grid, stream);
        if (!gla) { if (CFG_NAIVE_ATTN) hipLaunchKernelGGL(ref_attn, dim3(T * 16), dim3(128), 0, stream, a, li); else launch_range(a, pb + LP_CORE, pb + LP_CORE + 1, grid, stream); }
        else { if (CFG_NAIVE_GLA) hipLaunchKernelGGL(ref_gla, dim3(18 * 4 * 2 * 64), dim3(256), 0, stream, a, li); else launch_range(a, pb + LP_CORE, pb + LP_CORE + 1, grid, stream);
               launch_range(a, pb + LP_GATE, pb + LP_GATE + 1, grid, stream); }
        if (CFG_NAIVE_GEMM) launch_ref_gemm(AO, (const bf16*)(ws + WS_WO) + (size_t)l * D * D, T, D, D, E8F32{Y, D}, stream); else launch_range(a, pb + LP_WO, pb + LP_WO + 1, grid, stream);
        launch_range(a, pb + LP_ROWMID, pb + LP_ROWMID + 1, grid, stream);
        if (CFG_NAIVE_GEMM) launch_ref_gemm(H, (const bf16*)(ws + WS_W1) + (size_t)l * FF * D, T, FF, D, E8Relu2{HID, FF}, stream); else launch_range(a, pb + LP_W1, pb + LP_W1 + 1, grid, stream);
        if (CFG_NAIVE_GEMM) launch_ref_gemm(HID, (const bf16*)(ws + WS_W2) + (size_t)l * D * FF, T, D, FF, E8F32{Y, D}, stream); else launch_range(a, pb + LP_W2, pb + LP_W2 + 1, grid, stream);
        launch_range(a, pb + LP_ROWEND, pb + LP_ROWEND + 1, grid, stream);
    }
#endif
}
```

```cpp
#include <hip/hip_runtime.h>
#include <cstdio>
#include <cstdint>

#ifndef CFG_NAIVE_GEMM
#define CFG_NAIVE_GEMM 0
#endif
#ifndef CFG_NAIVE_ATTN
#define CFG_NAIVE_ATTN 0
#endif
#ifndef CFG_NAIVE_GLA
#define CFG_NAIVE_GLA 0
#endif
#ifndef Y_BF16
#define Y_BF16 1
#endif
#ifndef OG_BF16
#define OG_BF16 1
#endif
#ifndef CFG_ONE_LAUNCH
#define CFG_ONE_LAUNCH 1
#endif

#define GAS __attribute__((address_space(1)))
#define LAS __attribute__((address_space(3)))
typedef unsigned short bf16;
typedef float f32x4 __attribute__((ext_vector_type(4)));
typedef float f32x2 __attribute__((ext_vector_type(2)));
typedef short bf16x8 __attribute__((ext_vector_type(8)));
typedef short bf16x4 __attribute__((ext_vector_type(4)));
typedef unsigned u32x4 __attribute__((ext_vector_type(4)));
typedef unsigned u32x2 __attribute__((ext_vector_type(2)));

constexpr int D = 2048, T_P = 4096, T_S = 2048, T = 6144, FF = 8192, NL = 4;
constexpr int NMIX = 6400;
constexpr int NQK_NA = 4096, NQK_GLA = 4352;
constexpr float EPS = 1e-6f;
constexpr float LOG2E = 1.4426950408889634f;

constexpr size_t MiB = 1u << 20;
constexpr size_t WS_CTL = 0, CTL_ZERO_BYTES = 1 * MiB;
constexpr size_t WS_MOD = 1 * MiB;
constexpr size_t WS_WMIX = 2 * MiB;
constexpr size_t WS_WO = 102 * MiB;
constexpr size_t WS_W1 = 134 * MiB;
constexpr size_t WS_W2 = 262 * MiB;
constexpr size_t WS_CK = 390 * MiB;
constexpr size_t WS_CVT = 394 * MiB;
constexpr size_t WS_H = 398 * MiB;
constexpr size_t WS_QK = 422 * MiB;
constexpr int VTP = T + 64;
constexpr size_t WS_VT = 470 * MiB;
constexpr size_t WS_TLR = 496 * MiB;
constexpr size_t WS_AO = 497 * MiB;
constexpr size_t WS_OG = 521 * MiB;
constexpr size_t WS_Y = 617 * MiB;
constexpr size_t WS_HID = 713 * MiB;
constexpr size_t WS_END = 809 * MiB;
constexpr int CW_BAR = 4096;

constexpr size_t OUT_X = 0;
constexpr size_t OUT_NK = 12582912, OUT_NV = 29360128, OUT_GLA = 46137344, OUT_TOTAL = 79691776;

__device__ __forceinline__ unsigned f2bf(float f) { unsigned u = __builtin_bit_cast(unsigned, f); return (u + 0x7fffu + ((u >> 16) & 1u)) >> 16; }
__device__ __forceinline__ unsigned pk2(float lo, float hi) { return f2bf(lo) | (f2bf(hi) << 16); }
__device__ __forceinline__ float bf2f(unsigned short b) { return __builtin_bit_cast(float, ((unsigned)b) << 16); }
__device__ __forceinline__ float bflo(unsigned w) { return __builtin_bit_cast(float, w << 16); }
__device__ __forceinline__ float bfhi(unsigned w) { return __builtin_bit_cast(float, w & 0xffff0000u); }
#define LDS_WAIT() asm volatile("s_waitcnt lgkmcnt(0)" ::: "memory")
#define VM_WAIT() asm volatile("s_waitcnt vmcnt(0)" ::: "memory")

namespace pg8 {
#define PG8_LAS __attribute__((address_space(3)))
typedef unsigned short bf16_t;
typedef short bf16x8 __attribute__((ext_vector_type(8)));
typedef float f32x4 __attribute__((ext_vector_type(4)));
typedef unsigned u32x4 __attribute__((ext_vector_type(4)));
constexpr int BM = 256, BK = 64, HALF = 128, HTB = HALF * BK * 2  , STAGE_BYTES = 8 * HTB, NXCD = 8, WGM = 8;

__host__ __device__ __forceinline__ int lds_byte(int r, int c) { const int st = (r >> 4) * 2 + (c >> 5), rr = r & 15, cc = c & 31, ob = rr * 64 + cc * 2; return st * 1024 + (ob ^ (((ob >> 9) & 1) << 5)); }
__host__ __device__ __forceinline__ void stage_rc(int b, int& R, int& C) { const int st = b / 1024, sb = b % 1024, swz = sb ^ (((sb >> 9) & 1) << 5); R = (st >> 1) * 16 + swz / 64; C = (st & 1) * 32 + (swz % 64) / 2; }
__host__ __device__ __forceinline__ int perm32(int rho) { const int n = rho >> 4, i = rho & 15; return 8 * (i >> 2) + 4 * n + (i & 3); }

struct Unit { int pm, pn, k0, nt, part; };
struct Gemm { const bf16_t* A; const bf16_t* Bt; int M, N, K; };

struct StaticOrder {
    int nM, nN, nwg, G, c;
    __host__ __device__ void init(int M, int N, int G_, int c_) { nM = M / BM; nN = N / BM; nwg = nM * nN; G = G_; c = c_; }
    __host__ __device__ bool next(int i, Unit& u) const {
        const long L = (long)i * G + c; if (L >= nwg) return false;
        int wgid = (int)L; { const int q = nwg / NXCD, r = nwg % NXCD, xcd = wgid % NXCD, off = wgid / NXCD; wgid = (xcd < r ? xcd * (q + 1) : r * (q + 1) + (xcd - r) * q) + off; }
        const int nig = WGM * nN, gid = wgid / nig, fm = gid * WGM, gsz = (nM - fm) < WGM ? (nM - fm) : WGM;
        u.pm = fm + ((wgid % nig) % gsz); u.pn = (wgid % nig) / gsz; u.k0 = 0; u.nt = 0; u.part = 0; return true;
    }
    __device__ __forceinline__ void a_ready(const Unit&) const {}
    __device__ __forceinline__ void done(const Unit&) const {}
};

__device__ __forceinline__ unsigned cvt_pk_bf16(float lo, float hi) { unsigned r; asm volatile("v_cvt_pk_bf16_f32 %0, %1, %2" : "=v"(r) : "v"(lo), "v"(hi)); return r; }

template <class Epi, class Sched, bool ALIGN_EPI = false, bool SP2 = false>
__device__ __forceinline__ void gemm_phase(PG8_LAS unsigned char* lds, const Gemm g, const Sched& S, const Epi& E) {
    int tid_l = threadIdx.x; asm volatile("" : "+v"(tid_l)); const int tid = tid_l, wid = __builtin_amdgcn_readfirstlane(tid >> 6), lane = tid & 63, wr = wid >> 2, wc = wid & 3, fr = lane & 15, fq = lane >> 4;
    const int K = g.K;
    unsigned voffA[2], voffB[2];
#pragma unroll
    for (int i = 0; i < 2; ++i) { int R, C; stage_rc(tid * 16 + i * 8192, R, C); const int Rb = Epi::PERM ? ((R & ~31) + perm32(R & 31)) : R;
        voffA[i] = (unsigned)(R * K + C) * 2u; voffB[i] = (unsigned)(Rb * K + C) * 2u; }
    const size_t kstep = (size_t)(BK * 2);
    const size_t hstep = (size_t)HALF * K * 2;
    const size_t tstep = 2 * hstep;
    const unsigned ldsw = (unsigned)wid * 1024u;
    const int aoff = lds_byte(wr * 64 + fr, fq * 8), boff = lds_byte(wc * 32 + fr, fq * 8);
#define PG8_SA(b, h) (((b) * 2 + (h)) * HTB)
#define PG8_SB(b, h) ((4 + (b) * 2 + (h)) * HTB)
#define PG8_STAGE(bufoff, gbase, voff) do { _Pragma("unroll") for (int _i = 0; _i < 2; ++_i) \
        __builtin_amdgcn_global_load_lds((const unsigned*)((const char*)(gbase) + (voff)[_i]), (PG8_LAS unsigned*)(lds + (bufoff) + ldsw + _i * 8192), 16, 0, 0); } while (0)
#define PG8_LDA(dst, b, h) do { _Pragma("unroll") for (int m = 0; m < 4; ++m) _Pragma("unroll") for (int k = 0; k < 2; ++k) dst[m][k] = *(const PG8_LAS bf16x8*)(lds + PG8_SA(b, h) + aoff + m * 2048 + k * 1024); } while (0)
#define PG8_LDB(dst, b, h) do { _Pragma("unroll") for (int n = 0; n < 2; ++n) _Pragma("unroll") for (int k = 0; k < 2; ++k) dst[n][k] = *(const PG8_LAS bf16x8*)(lds + PG8_SB(b, h) + boff + n * 2048 + k * 1024); } while (0)
#define PG8_MMA(ai, bj, At, Bt) do { __builtin_amdgcn_s_setprio(1); _Pragma("unroll") for (int m = 0; m < 4; ++m) _Pragma("unroll") for (int n = 0; n < 2; ++n) _Pragma("unroll") for (int k = 0; k < 2; ++k) \
        acc[ai][bj][m][n] = __builtin_amdgcn_mfma_f32_16x16x32_bf16(Bt[n][k], At[m][k], acc[ai][bj][m][n], 0, 0, 0); __builtin_amdgcn_s_setprio(0); } while (0)
#define PG8_WAIT_V(n) asm volatile("s_waitcnt vmcnt(" #n ")" ::: "memory")
#define PG8_WAIT_L(n) asm volatile("s_waitcnt lgkmcnt(" #n ")" ::: "memory")
#define PG8_BAR __builtin_amdgcn_s_barrier()
#define PG8_SCHED __builtin_amdgcn_sched_barrier(0)
    Unit cur, nxt; int ui = 0;
    if (!S.next(0, cur)) return;
    f32x4 acc[2][2][4][2];
#pragma unroll
    for (int a = 0; a < 2; ++a)
#pragma unroll
        for (int b = 0; b < 2; ++b)
#pragma unroll
            for (int m = 0; m < 4; ++m)
#pragma unroll
                for (int n = 0; n < 2; ++n) acc[a][b][m][n] = (f32x4){0.f, 0.f, 0.f, 0.f};
    bf16x8 At[4][2], B0[2][2], B1[2][2];
    const char* cA = (const char*)g.A + (size_t)cur.pm * tstep + (size_t)cur.k0 * 2; const char* cB = (const char*)g.Bt + (size_t)cur.pn * tstep + (size_t)cur.k0 * 2;
    S.a_ready(cur);
    if constexpr (SP2) {
        PG8_STAGE(PG8_SB(0, 0), cB, voffB); PG8_STAGE(PG8_SB(0, 1), cB + hstep, voffB); PG8_STAGE(PG8_SA(0, 0), cA, voffA); PG8_STAGE(PG8_SA(0, 1), cA + hstep, voffA);
        if (wr == 1) PG8_BAR;
        PG8_WAIT_V(2); PG8_BAR;
        PG8_STAGE(PG8_SB(1, 0), cB + kstep, voffB); PG8_STAGE(PG8_SA(1, 0), cA + kstep, voffA); PG8_STAGE(PG8_SB(1, 1), cB + hstep + kstep, voffB);
        PG8_WAIT_V(6); PG8_BAR;
    } else {
        PG8_STAGE(PG8_SB(0, 0), cB, voffB); PG8_STAGE(PG8_SA(0, 0), cA, voffA); PG8_STAGE(PG8_SB(0, 1), cB + hstep, voffB); PG8_STAGE(PG8_SA(0, 1), cA + hstep, voffA);
        if (wr == 1) PG8_BAR;
        PG8_WAIT_V(4); PG8_BAR;
        PG8_STAGE(PG8_SB(1, 0), cB + kstep, voffB); PG8_STAGE(PG8_SA(1, 0), cA + kstep, voffA); PG8_STAGE(PG8_SB(1, 1), cB + hstep + kstep, voffB);
        PG8_WAIT_V(6); PG8_BAR;
    }
    for (;;) {
        const bool has_next = S.next(ui + 1, nxt);
        const char* nA = has_next ? (const char*)g.A + (size_t)nxt.pm * tstep + (size_t)nxt.k0 * 2 : cA; const char* nB = has_next ? (const char*)g.Bt + (size_t)nxt.pn * tstep + (size_t)nxt.k0 * 2 : cB;
        const int nt = cur.nt ? cur.nt : K / BK;
        for (int t = 0; t < nt; t += 2) {
            const bool last = (t == nt - 2);
            const char* a1 = cA + (size_t)(t + 1) * kstep;
            const char* a2 = last ? nA : cA + (size_t)(t + 2) * kstep; const char* b2 = last ? nB : cB + (size_t)(t + 2) * kstep;
            const char* a3 = a2 + kstep; const char* b3 = b2 + kstep;
            if (last && has_next) S.a_ready(nxt);
            if constexpr (SP2) {
            PG8_LDB(B0, 0, 0); PG8_LDB(B1, 0, 1); PG8_SCHED; PG8_LDA(At, 0, 0); PG8_STAGE(PG8_SA(1, 1), a1 + hstep, voffA);
            PG8_WAIT_V(8); PG8_WAIT_L(0); PG8_BAR; PG8_MMA(0, 0, At, B0); PG8_MMA(0, 1, At, B1); PG8_BAR; PG8_SCHED;
            PG8_LDA(At, 0, 1); PG8_STAGE(PG8_SB(0, 0), b2, voffB); PG8_STAGE(PG8_SB(0, 1), b2 + hstep, voffB); PG8_STAGE(PG8_SA(0, 0), a2, voffA);
            PG8_WAIT_V(8); PG8_WAIT_L(0); PG8_BAR; PG8_MMA(1, 0, At, B0); PG8_MMA(1, 1, At, B1); PG8_BAR; PG8_SCHED;
            PG8_LDB(B0, 1, 0); PG8_LDB(B1, 1, 1); PG8_SCHED; PG8_LDA(At, 1, 0); PG8_STAGE(PG8_SA(0, 1), a2 + hstep, voffA);
            PG8_WAIT_V(8); PG8_WAIT_L(0); PG8_BAR; PG8_MMA(0, 0, At, B0); PG8_MMA(0, 1, At, B1); PG8_BAR; PG8_SCHED;
            PG8_LDA(At, 1, 1); PG8_STAGE(PG8_SB(1, 0), b3, voffB); PG8_STAGE(PG8_SB(1, 1), b3 + hstep, voffB); PG8_STAGE(PG8_SA(1, 0), a3, voffA);
            PG8_WAIT_V(8); PG8_WAIT_L(0); PG8_BAR; PG8_MMA(1, 0, At, B0); PG8_MMA(1, 1, At, B1); PG8_BAR; PG8_SCHED;
            } else {
            PG8_LDB(B0, 0, 0); PG8_SCHED; PG8_LDA(At, 0, 0); PG8_STAGE(PG8_SA(1, 1), a1 + hstep, voffA);
            PG8_WAIT_L(8); PG8_BAR; PG8_WAIT_L(0); PG8_MMA(0, 0, At, B0); PG8_BAR; PG8_SCHED;
            PG8_LDB(B1, 0, 1); PG8_STAGE(PG8_SB(0, 0), b2, voffB);
            PG8_BAR; PG8_WAIT_L(0); PG8_MMA(0, 1, At, B1); PG8_BAR;
            PG8_LDA(At, 0, 1); PG8_STAGE(PG8_SA(0, 0), a2, voffA);
            PG8_BAR; PG8_WAIT_L(0); PG8_MMA(1, 0, At, B0); PG8_BAR; PG8_SCHED;
            PG8_STAGE(PG8_SB(0, 1), b2 + hstep, voffB);
            PG8_WAIT_V(6); PG8_BAR; PG8_MMA(1, 1, At, B1); PG8_BAR;
            PG8_LDB(B0, 1, 0); PG8_SCHED; PG8_LDA(At, 1, 0); PG8_STAGE(PG8_SA(0, 1), a2 + hstep, voffA);
            PG8_WAIT_L(8); PG8_BAR; PG8_WAIT_L(0); PG8_MMA(0, 0, At, B0); PG8_BAR; PG8_SCHED;
            PG8_LDB(B1, 1, 1); PG8_STAGE(PG8_SB(1, 0), b3, voffB);
            PG8_BAR; PG8_WAIT_L(0); PG8_MMA(0, 1, At, B1); PG8_BAR;
            PG8_LDA(At, 1, 1); PG8_STAGE(PG8_SA(1, 0), a3, voffA);
            PG8_BAR; PG8_WAIT_L(0); PG8_MMA(1, 0, At, B0); PG8_BAR; PG8_SCHED;
            PG8_STAGE(PG8_SB(1, 1), b3 + hstep, voffB);
            PG8_WAIT_V(6); PG8_BAR; PG8_MMA(1, 1, At, B1); PG8_BAR;
            }
        }
        if constexpr (ALIGN_EPI) { if (wr == 0) PG8_BAR; }
        if constexpr (!Epi::AFTER_DRAIN) { E(acc, cur, wr, wc, fr, fq); S.done(cur); }
        if (!has_next) break;
#pragma unroll
        for (int a = 0; a < 2; ++a)
#pragma unroll
            for (int b = 0; b < 2; ++b)
#pragma unroll
                for (int m = 0; m < 4; ++m)
#pragma unroll
                    for (int n = 0; n < 2; ++n) acc[a][b][m][n] = (f32x4){0.f, 0.f, 0.f, 0.f};
        cur = nxt; cA = nA; cB = nB; ++ui;
        if constexpr (ALIGN_EPI) { if (wr == 1) PG8_BAR; }
    }
    PG8_WAIT_V(0);
    if constexpr (!ALIGN_EPI) { if (wr == 0) PG8_BAR; }
    PG8_BAR;
    if constexpr (Epi::AFTER_DRAIN) { E.fused(acc, cur, wr, wc, fr, fq, lds, wid, lane); S.done(cur); }
#undef PG8_SA
#undef PG8_SB
#undef PG8_STAGE
#undef PG8_LDA
#undef PG8_LDB
#undef PG8_MMA
#undef PG8_WAIT_V
#undef PG8_WAIT_L
#undef PG8_BAR
#undef PG8_SCHED
}
}
#define XB_TMO      128
#define XB_XCNT(j)  (256  + 64 * (j))
#define XB_XSUB(j)  (1280 + 64 * (j))
#define XB_XGEN(j)  (2304 + 64 * (j))
#define XB_TOP      3328
#define XB_TOPGEN   3392
#define XCD_BAR_WORDS 3456
#define XB_SPIN_CAP (1u << 18)

__device__ __forceinline__ unsigned xb_ld(unsigned* p)              { return __hip_atomic_load(p, __ATOMIC_RELAXED, __HIP_MEMORY_SCOPE_AGENT); }
__device__ __forceinline__ unsigned xb_add(unsigned* p, unsigned v) { return __hip_atomic_fetch_add(p, v, __ATOMIC_RELAXED, __HIP_MEMORY_SCOPE_AGENT); }
__device__ __forceinline__ unsigned xb_xcc_id() { return (unsigned)__builtin_amdgcn_s_getreg((3 << 11) | 20) & 0xFu; }
#define XB_SPIN(cond, bar) do { unsigned _sp = 0; while (cond) { __builtin_amdgcn_s_sleep(1); \
    if ((++_sp & 255u) == 0u) { if (xb_ld(&(bar)[XB_TMO])) break; if (_sp > XB_SPIN_CAP) { atomicAdd(&(bar)[XB_TMO], 1u); break; } } } } while (0)

struct XcdBarrier {
    unsigned* bar; unsigned x;
    volatile LAS unsigned* st;
};

__device__ __forceinline__ XcdBarrier xcd_barrier_post(unsigned* bar, volatile LAS unsigned* st) {
    XcdBarrier b; b.bar = bar; b.x = xb_xcc_id(); b.st = st;
    if (threadIdx.x == 0) (void)xb_add(&bar[XB_XCNT(b.x)], 1u);
    return b;
}
__device__ __forceinline__ void xcd_barrier_complete(unsigned* bar, unsigned x, unsigned& nloc, unsigned& nx) {
    const unsigned G = gridDim.x * gridDim.y * gridDim.z;
    unsigned sum, cnt, mine, sp = 0u;
    for (;;) {
        sum = 0u; cnt = 0u; mine = 0u;
#pragma unroll
        for (unsigned j = 0; j < 16; ++j) { const unsigned c = xb_ld(&bar[XB_XCNT(j)]); sum += c; cnt += (c > 0u) ? 1u : 0u; mine = (j == x) ? c : mine; }
        if (sum == G) break;
        __builtin_amdgcn_s_sleep(1);
        if ((++sp & 255u) == 0u) { if (xb_ld(&bar[XB_TMO])) break; if (sp > XB_SPIN_CAP) { atomicAdd(&bar[XB_TMO], 1u); break; } }
    }
    nloc = mine > 0u ? mine : 1u; nx = cnt > 0u ? cnt : 1u;
}

__device__ __forceinline__ void xcd_barrier(const XcdBarrier& b) {
    asm volatile("s_waitcnt vmcnt(0)" ::: "memory");
    __syncthreads();
    if (threadIdx.x == 0) {
        unsigned* bar = b.bar;
        __builtin_amdgcn_s_waitcnt(0);
        unsigned nloc = b.st[0], nx = b.st[1];
        if (nloc == 0u) { xcd_barrier_complete(bar, b.x, nloc, nx); b.st[0] = nloc; b.st[1] = nx; }
        const unsigned old = xb_add(&bar[XB_XSUB(b.x)], 1u);
        const unsigned gen = old / nloc;
        if (old + 1u == (gen + 1u) * nloc) {
            __builtin_amdgcn_fence(__ATOMIC_RELEASE, "agent");
            asm volatile("s_waitcnt vmcnt(0)" ::: "memory");
            const unsigned og = xb_add(&bar[XB_TOP], 1u);
            const unsigned tg = og / nx;
            if (og + 1u == (tg + 1u) * nx) xb_add(&bar[XB_TOPGEN], 1u);
            else XB_SPIN(xb_ld(&bar[XB_TOPGEN]) == tg, bar);
            __builtin_amdgcn_fence(__ATOMIC_ACQUIRE, "agent");
            xb_add(&bar[XB_XGEN(b.x)], 1u);
            asm volatile("s_waitcnt vmcnt(0)" ::: "memory");
        } else {
            XB_SPIN(xb_ld(&bar[XB_XGEN(b.x)]) == gen, bar);
            __builtin_amdgcn_fence(__ATOMIC_ACQUIRE, "agent");
            asm volatile("s_waitcnt vmcnt(0)" ::: "memory");
        }
    }
    __syncthreads();
}


typedef __bf16 bf16x2_t __attribute__((ext_vector_type(2)));
__device__ __forceinline__ unsigned cvtpk(float lo, float hi) { f32x2 v = {lo, hi}; bf16x2_t b = __builtin_convertvector(v, bf16x2_t); return __builtin_bit_cast(unsigned, b); }
__device__ __forceinline__ float wave_sum(float v) {
#pragma unroll
    for (int o = 1; o < 64; o <<= 1) v += __shfl_xor(v, o);
    return v;
}
__device__ __forceinline__ float silu_f(float x) { return x / (1.f + __expf(-x)); }
__device__ __forceinline__ float logsigmoid_f(float z) { return fminf(z, 0.f) - __logf(1.f + __expf(-fabsf(z))); }
__device__ __forceinline__ int cond_of_row(int r) { return r < T_P ? 0 : 1 + ((r - T_P) >> 10); }
__device__ __forceinline__ int clampi(int v, int lo, int hi) { return v < lo ? lo : (v > hi ? hi : v); }

#ifndef ADA_DEFER
#define ADA_DEFER 1
#endif
#ifndef EPI_NT
#define EPI_NT 0
#endif
__device__ __forceinline__ void st16(void* p, u32x4 w) {
    if (EPI_NT == 2) asm volatile("global_store_dwordx4 %0, %1, off sc1\n\ts_nop 2" :: "v"(p), "v"(w) : "memory");
    else if (EPI_NT == 1) __builtin_nontemporal_store(w, (u32x4*)p); else *(u32x4*)p = w; }
struct Args { const float* in[21]; float* out; unsigned char* ws; int ph_lo, ph_hi; };
enum { IN_XP = 0, IN_XS, IN_CK, IN_CV, IN_SG, IN_C, IN_CCTX, IN_WADA, IN_BADA, IN_NORMG, IN_WQKV, IN_WONA, IN_RPB, IN_WQKVG, IN_WA1, IN_WA2, IN_BA, IN_GHEAD, IN_WOGLA, IN_W1, IN_W2 };
constexpr int PH_PRO = 0, PH_R0 = 1, PH_L0 = 2, PH_PER_LAYER = 8, NPH = PH_L0 + NL * PH_PER_LAYER;
enum { LP_MIX = 0, LP_CORE, LP_GATE, LP_WO, LP_ROWMID, LP_W1, LP_W2, LP_ROWEND };

struct E8NaQK {
    bf16* QK; float* newk; int li;
    __device__ __forceinline__ void store8(int row, int col, const float (&v)[8]) const {
        u32x4 w; w.x = cvtpk(v[0], v[1]); w.y = cvtpk(v[2], v[3]); w.z = cvtpk(v[4], v[5]); w.w = cvtpk(v[6], v[7]);
        { const int kpart = col >= 2048, c = col - 2048 * kpart, h = c >> 7, d = c & 127;
          st16(QK + (size_t)kpart * T * 2048 + ((size_t)h * T + row) * 128 + d, w); }
        if (col >= 2048 && row < T_P) {
            const int b = row >> 8, s = row & 255, c = col - 2048, h = c >> 7, d = c & 127;
            float* p = newk + ((((size_t)b * 2 + li) * 16 + h) * 256 + s) * 128 + d;
            *(f32x4*)p = (f32x4){v[0], v[1], v[2], v[3]}; *(f32x4*)(p + 4) = (f32x4){v[4], v[5], v[6], v[7]};
        }
    }
};
struct E8VT {
    bf16* VT; float* newv; int li;
    __device__ __forceinline__ void store8(int row, int col, const float (&v)[8]) const {
        u32x4 w; w.x = cvtpk(v[0], v[1]); w.y = cvtpk(v[2], v[3]); w.z = cvtpk(v[4], v[5]); w.w = cvtpk(v[6], v[7]);
        st16(VT + (size_t)row * VTP + col, w);
        if (newv && col < T_P) {
            const int b = col >> 8, s = col & 255, h = row >> 7, d = row & 127;
            float* p = newv + ((((size_t)b * 2 + li) * 16 + h) * 256 + s) * 128 + d;
#pragma unroll
            for (int e = 0; e < 8; ++e) p[(size_t)e * 128] = v[e];
        }
    }
};
struct E8GlaQKG {
    bf16* QK; float* TLR;
    __device__ __forceinline__ void store8(int row, int col, const float (&v)[8]) const {
        if (col < 4096) {
            u32x4 w; w.x = cvtpk(v[0], v[1]); w.y = cvtpk(v[2], v[3]); w.z = cvtpk(v[4], v[5]); w.w = cvtpk(v[6], v[7]);
            st16(QK + (size_t)row * 4096 + col, w);
        } else if (col < 4128) {
            float* p = TLR + (size_t)row * 32 + (col - 4096);
            *(f32x4*)p = (f32x4){v[0], v[1], v[2], v[3]}; *(f32x4*)(p + 4) = (f32x4){v[4], v[5], v[6], v[7]};
        }
    }
};
struct E8F32 {
    float* Y; int ldc;
    __device__ __forceinline__ void store8(int row, int col, const float (&v)[8]) const {
        float* p = Y + (size_t)row * ldc + col;
        *(f32x4*)p = (f32x4){v[0], v[1], v[2], v[3]}; *(f32x4*)(p + 4) = (f32x4){v[4], v[5], v[6], v[7]};
    }
};
struct E8Bf16 {
    bf16* O; int ldc;
    __device__ __forceinline__ void store8(int row, int col, const float (&v)[8]) const {
        u32x4 w; w.x = cvtpk(v[0], v[1]); w.y = cvtpk(v[2], v[3]); w.z = cvtpk(v[4], v[5]); w.w = cvtpk(v[6], v[7]);
        st16(O + (size_t)row * ldc + col, w);
    }
};
struct E8Relu2 {
    bf16* O; int ldc;
    __device__ __forceinline__ void store8(int row, int col, const float (&v)[8]) const {
        float r[8];
#pragma unroll
        for (int e = 0; e < 8; ++e) { const float t = fmaxf(v[e], 0.f); r[e] = t * t; }
        u32x4 w; w.x = cvtpk(r[0], r[1]); w.y = cvtpk(r[2], r[3]); w.z = cvtpk(r[4], r[5]); w.w = cvtpk(r[6], r[7]);
        st16(O + (size_t)row * ldc + col, w);
    }
};
template <class E8> struct EpiWrap {
    static constexpr bool PERM = true, AFTER_DRAIN = false;
    E8 e;
    __device__ __forceinline__ void operator()(const pg8::f32x4 (&acc)[2][2][4][2], const pg8::Unit& u, int wr, int wc, int fr, int fq) const {
        const int row0 = u.pm * 256 + wr * 64 + fr, col0 = u.pn * 256 + wc * 32 + 8 * fq;
#pragma unroll
        for (int ai = 0; ai < 2; ++ai)
#pragma unroll
            for (int m = 0; m < 4; ++m)
#pragma unroll
                for (int bj = 0; bj < 2; ++bj) {
                    const pg8::f32x4 a = acc[ai][bj][m][0], b = acc[ai][bj][m][1];
                    const float v[8] = {a[0], a[1], a[2], a[3], b[0], b[1], b[2], b[3]};
                    e.store8(row0 + ai * 128 + m * 16, col0 + bj * 128, v);
                }
    }
};

constexpr int W2_NT_MAIN = 100;
struct SplitKOrder {
    int c;
    __device__ static void map(int L, pg8::Unit& u) {
        const int nM = 24, nN = 8, nwg = 192;
        int wgid = L; { const int q = nwg / 8, xcd = wgid % 8, off = wgid / 8; wgid = xcd * q + off; }
        const int nig = 8 * nN, gid = wgid / nig, fm = gid * 8, gsz = (nM - fm) < 8 ? (nM - fm) : 8;
        u.pm = fm + ((wgid % nig) % gsz); u.pn = (wgid % nig) / gsz;
    }
    __device__ bool next(int i, pg8::Unit& u) const {
        if (c < 192) { if (i > 0) return false; map(c, u); u.k0 = 0; u.nt = W2_NT_MAIN; u.part = 0; return true; }
        if (i >= 3) return false;
        map(3 * (c - 192) + i, u); u.k0 = W2_NT_MAIN * 64; u.nt = 128 - W2_NT_MAIN; u.part = 1; return true;
    }
    __device__ __forceinline__ void a_ready(const pg8::Unit&) const {}
    __device__ __forceinline__ void done(const pg8::Unit&) const {}
};
struct EpiF32Part {
    static constexpr bool PERM = true, AFTER_DRAIN = false;
    float* Y0; float* Y1;
    __device__ __forceinline__ void operator()(const pg8::f32x4 (&acc)[2][2][4][2], const pg8::Unit& u, int wr, int wc, int fr, int fq) const {
        const int row0 = u.pm * 256 + wr * 64 + fr, col0 = u.pn * 256 + wc * 32 + 8 * fq;
        float* Y = u.part ? Y1 : Y0;
#pragma unroll
        for (int ai = 0; ai < 2; ++ai)
#pragma unroll
            for (int m = 0; m < 4; ++m)
#pragma unroll
                for (int bj = 0; bj < 2; ++bj) {
                    float* p = Y + (size_t)(row0 + ai * 128 + m * 16) * D + col0 + bj * 128;
                    *(f32x4*)p = acc[ai][bj][m][0]; *(f32x4*)(p + 4) = acc[ai][bj][m][1];
                }
    }
};

__device__ __forceinline__ void tr_item(const float* src, size_t ldsrc, bf16* dst, size_t lddst, LAS float* scr, int lane) {
    const float* sp_ = src + (size_t)(lane >> 5) * ldsrc + (lane & 31); LAS float* dp_ = scr + (lane >> 5) * 33 + (lane & 31);
#pragma unroll 1
    for (int h = 0; h < 2; ++h, sp_ += 32 * ldsrc, dp_ += 32 * 33) {
        float tv[16];
#pragma unroll
        for (int i = 0; i < 16; ++i) tv[i] = __builtin_nontemporal_load(sp_ + (size_t)(2 * i) * ldsrc);
#pragma unroll
        for (int i = 0; i < 16; ++i) dp_[2 * i * 33] = tv[i];
    }
    LDS_WAIT(); asm volatile("" ::: "memory");
    const int c = lane & 7;
#pragma unroll
    for (int j = 0; j < 4; ++j) { const int n = (lane >> 3) + 8 * j; const LAS float* s = scr + (8 * c) * 33 + n;
        u32x4 o; o.x = cvtpk(s[0 * 33], s[1 * 33]); o.y = cvtpk(s[2 * 33], s[3 * 33]); o.z = cvtpk(s[4 * 33], s[5 * 33]); o.w = cvtpk(s[6 * 33], s[7 * 33]);
        *(u32x4*)(dst + (size_t)n * lddst + 8 * c) = o; }
    LDS_WAIT(); asm volatile("" ::: "memory");
}
constexpr int PRO_SCR_BYTES = 8448, PRO_SILU_OFF = 8 * PRO_SCR_BYTES  , PRO_PART_OFF = PRO_SILU_OFF + 3 * 2048 * 4  ;
constexpr int LY_ADA = 192, LY_TR = 3072, LY_A1 = 32, LY_ITEMS = LY_ADA + LY_TR + LY_A1;

__device__ __forceinline__ void silu_table(const Args& a, LAS unsigned char* lds, int tid) {
    LAS float* sil = (LAS float*)(lds + PRO_SILU_OFF);
    for (int e = tid; e < 3 * 2048; e += 512) { const int c = e >> 11, k = e & 2047; const float x = c == 0 ? a.in[IN_CCTX][k] : a.in[IN_C][(c - 1) * 2048 + k]; sil[e] = silu_f(x); }
    __syncthreads();
}
__device__ __forceinline__ void ada_layer(const Args& a, LAS unsigned char* lds, int l, int b0, int nb, int tid) {
    const int lane = tid & 63, wave = __builtin_amdgcn_readfirstlane(tid >> 6);
    LAS float* sil = (LAS float*)(lds + PRO_SILU_OFF);
    LAS float* part = (LAS float*)(lds + PRO_PART_OFF);
    for (int cg = b0; cg < LY_ADA; cg += nb) {
        const float* W = a.in[IN_WADA] + (size_t)l * 2048 * 12288 + cg * 64 + lane;
        float a0 = 0.f, a1 = 0.f, a2 = 0.f;
        const int k0 = wave * 256;
#pragma unroll 1
        for (int kc = 0; kc < 256; kc += 16) {
            float wv[16];
#pragma unroll
            for (int k = 0; k < 16; ++k) wv[k] = __builtin_nontemporal_load(W + (size_t)(k0 + kc + k) * 12288);
#pragma unroll
            for (int k = 0; k < 16; ++k) { a0 += sil[k0 + kc + k] * wv[k]; a1 += sil[2048 + k0 + kc + k] * wv[k]; a2 += sil[4096 + k0 + kc + k] * wv[k]; }
        }
        part[(wave * 3 + 0) * 64 + lane] = a0; part[(wave * 3 + 1) * 64 + lane] = a1; part[(wave * 3 + 2) * 64 + lane] = a2;
        __syncthreads();
        if (tid < 192) { const int c = tid >> 6, col = tid & 63; float sacc = 0.f;
#pragma unroll
            for (int w = 0; w < 8; ++w) sacc += part[(w * 3 + c) * 64 + col];
            ((float*)(a.ws + WS_MOD))[((size_t)l * 3 + c) * 12288 + cg * 64 + col] = sacc + a.in[IN_BADA][l * 12288 + cg * 64 + col]; }
        __syncthreads();
    }
}
__device__ __forceinline__ void convert_weights(const Args& a, LAS unsigned char* lds, int l, int it_lo, int it_hi, int b0, int nb, int tid) {
    const int lane = tid & 63, wave = __builtin_amdgcn_readfirstlane(tid >> 6);
    LAS float* scr = (LAS float*)(lds + wave * PRO_SCR_BYTES);
    unsigned char* ws = a.ws;
    const int i = l >> 1; const bool gla = l & 1;
    for (int it = it_lo + b0; it < it_hi; it += nb) {
        int r = it;
        if (r < LY_TR) {
            if (r < 768) {
                const int kb = r / 24, nb2 = r % 24;
                const float* src = (gla ? a.in[IN_WQKVG] : a.in[IN_WQKV]) + (size_t)i * 2048 * 6144;
                int db = nb2; if (gla) { if (nb2 >= 16) db = 8 + (nb2 - 16); else if (nb2 >= 8) db = 17 + (nb2 - 8); }
                bf16* dst = (bf16*)(ws + WS_WMIX) + (size_t)l * NMIX * D;
                tr_item(src + (size_t)(kb * 64) * 6144 + nb2 * 256 + wave * 32, 6144, dst + (size_t)(db * 256 + wave * 32) * D + kb * 64, D, scr, lane);
            } else if (r < 1024) {
                r -= 768; const int kb = r / 8, nb2 = r % 8;
                const float* src = (gla ? a.in[IN_WOGLA] : a.in[IN_WONA]) + (size_t)i * 2048 * 2048;
                bf16* dst = (bf16*)(ws + WS_WO) + (size_t)l * D * D;
                tr_item(src + (size_t)(kb * 64) * 2048 + nb2 * 256 + wave * 32, 2048, dst + (size_t)(nb2 * 256 + wave * 32) * D + kb * 64, D, scr, lane);
            } else if (r < 2048) {
                r -= 1024; const int kb = r / 32, nb2 = r % 32;
                const float* src = a.in[IN_W1] + (size_t)l * 2048 * 8192;
                bf16* dst = (bf16*)(ws + WS_W1) + (size_t)l * FF * D;
                tr_item(src + (size_t)(kb * 64) * 8192 + nb2 * 256 + wave * 32, 8192, dst + (size_t)(nb2 * 256 + wave * 32) * D + kb * 64, D, scr, lane);
            } else {
                r -= 2048; const int kb = r / 8, nb2 = r % 8;
                const float* src = a.in[IN_W2] + (size_t)l * 8192 * 2048;
                bf16* dst = (bf16*)(ws + WS_W2) + (size_t)l * D * FF;
                tr_item(src + (size_t)(kb * 64) * 2048 + nb2 * 256 + wave * 32, 2048, dst + (size_t)(nb2 * 256 + wave * 32) * FF + kb * 64, FF, scr, lane);
            }
            continue;
        }
        r -= LY_TR;
        if (gla) {
            const int p = r;
            bf16* dst = (bf16*)(ws + WS_WMIX) + (size_t)l * NMIX * D + (size_t)4096 * D;
            for (int q = 0; q < 32; ++q) { const int e = tid + 512 * q, rr = e >> 11, k = e & 2047, prow = 8 * p + rr;
                float val = 0.f; if (prow < 32) val = a.in[IN_WA1][(((size_t)i * 2 + (prow >> 4)) * 2048 + k) * 16 + (prow & 15)];
                dst[(size_t)prow * D + k] = (bf16)f2bf(val); }
        }
    }
}
constexpr int CV_WITEMS = LY_TR + LY_A1;
#ifndef CVMIX
#define CVMIX 1100
#define CVWO 1500
#define CVW2 3104
#endif
constexpr int CV_MIX_END = CVMIX, CV_WO_END = CVWO, CV_W2_END = CVW2;
constexpr int PRO_CK = 512, PRO_CV = 128;
__device__ __forceinline__ void prologue_phase(const Args& a, LAS unsigned char* lds, int bid, int G, int tid) {
    const int lane = tid & 63, wave = __builtin_amdgcn_readfirstlane(tid >> 6);
    LAS float* scr = (LAS float*)(lds + wave * PRO_SCR_BYTES);
    unsigned char* ws = a.ws;
    silu_table(a, lds, tid);
    const bool defer = (G == 256);
    for (int l = 0; l < ((ADA_DEFER && defer) ? 1 : NL); ++l) ada_layer(a, lds, l, (bid + 64 * l) % G, G, tid);
    convert_weights(a, lds, 0, 0, CV_WITEMS, bid, G, tid);
    for (int l = 1; l < NL; ++l) convert_weights(a, lds, l, defer ? CV_W2_END : 0, CV_WITEMS, (bid + 37 * l) % G, G, tid);
    for (int r = bid; r < PRO_CK + PRO_CV; r += G) {
        if (r < PRO_CK) {
            const size_t e0 = ((size_t)r * 512 + tid) * 8;
            const f32x4 x0 = *(const f32x4*)(a.in[IN_CK] + e0), x1 = *(const f32x4*)(a.in[IN_CK] + e0 + 4);
            u32x4 w; w.x = cvtpk(x0[0], x0[1]); w.y = cvtpk(x0[2], x0[3]); w.z = cvtpk(x1[0], x1[1]); w.w = cvtpk(x1[2], x1[3]);
            *(u32x4*)((bf16*)(ws + WS_CK) + e0) = w;
        } else {
            const int rr = r - PRO_CK, mat = rr >> 1, kh = rr & 1, kb = kh * 2 + (wave >> 2), nb2 = wave & 3;
            tr_item(a.in[IN_CV] + (size_t)mat * 256 * 128 + (size_t)(kb * 64) * 128 + nb2 * 32, 128, (bf16*)(ws + WS_CVT) + (size_t)mat * 128 * 256 + (size_t)(nb2 * 32) * 256 + kb * 64, 256, scr, lane);
        }
    }
}

template <bool FIRST, bool UPD, bool EMIT, bool ADD2 = false>
__device__ __forceinline__ void row_phase(const Args& a, int gw, int ngw, int lane, const float* ga, const float* modU, int jgate, const float* gb, const float* modE, int jshift, int jscale) {
    float* X = a.out + OUT_X; const float* Y = (const float*)(a.ws + WS_Y); bf16* H = (bf16*)(a.ws + WS_H);
    const int rpw = (T + ngw - 1) / ngw, r0 = gw * rpw, r1 = (r0 + rpw < T) ? r0 + rpw : T;
    f32x4 c1[8], c2[8], c3[8];
    int cur = -1;
    for (int r = r0; r < r1; ++r) {
        const int cond = cond_of_row(r);
        if (cond != cur) {
            cur = cond;
            if (UPD) { const float* gate = modU + ((size_t)cond * 6 + jgate) * D;
#pragma unroll
                for (int j = 0; j < 8; ++j) c1[j] = *(const f32x4*)(gate + 256 * j + 4 * lane) * *(const f32x4*)(ga + 256 * j + 4 * lane); }
            if (EMIT) { const float* sh = modE + ((size_t)cond * 6 + jshift) * D; const float* sc = modE + ((size_t)cond * 6 + jscale) * D;
#pragma unroll
                for (int j = 0; j < 8; ++j) { c2[j] = *(const f32x4*)(gb + 256 * j + 4 * lane) * (*(const f32x4*)(sc + 256 * j + 4 * lane) + 1.f); c3[j] = *(const f32x4*)(sh + 256 * j + 4 * lane); } }
        }
        const float* xin = FIRST ? (r < T_P ? a.in[IN_XP] + (size_t)r * D : a.in[IN_XS] + (size_t)(r - T_P) * D) : X + (size_t)r * D;
        f32x4 x[8];
#pragma unroll
        for (int j = 0; j < 8; ++j) x[j] = *(const f32x4*)(xin + 256 * j + 4 * lane);
        if (UPD) {
            f32x4 y[8]; float ss = 0.f;
#pragma unroll
            for (int j = 0; j < 8; ++j) {
                if (Y_BF16) { const u32x2 yw = *(const u32x2*)((const bf16*)Y + (size_t)r * D + 256 * j + 4 * lane); y[j] = (f32x4){bflo(yw.x), bfhi(yw.x), bflo(yw.y), bfhi(yw.y)}; }
                else { y[j] = *(const f32x4*)(Y + (size_t)r * D + 256 * j + 4 * lane); if (ADD2) y[j] = y[j] + *(const f32x4*)(Y + (size_t)T * D + (size_t)r * D + 256 * j + 4 * lane); }
                ss += (y[j][0] * y[j][0] + y[j][1] * y[j][1]) + (y[j][2] * y[j][2] + y[j][3] * y[j][3]); }
            const float rinv = rsqrtf(wave_sum(ss) * (1.f / D) + EPS);
#pragma unroll
            for (int j = 0; j < 8; ++j) x[j] = x[j] + c1[j] * (y[j] * rinv);
        }
        if (FIRST || UPD) {
#pragma unroll
            for (int j = 0; j < 8; ++j) *(f32x4*)(X + (size_t)r * D + 256 * j + 4 * lane) = x[j];
        }
        if (EMIT) {
            float ss = 0.f;
#pragma unroll
            for (int j = 0; j < 8; ++j) ss += (x[j][0] * x[j][0] + x[j][1] * x[j][1]) + (x[j][2] * x[j][2] + x[j][3] * x[j][3]);
            const float rinv = rsqrtf(wave_sum(ss) * (1.f / D) + EPS);
#pragma unroll
            for (int j = 0; j < 8; ++j) { const f32x4 h = (x[j] * rinv) * c2[j] + c3[j];
                u32x2 w; w.x = cvtpk(h[0], h[1]); w.y = cvtpk(h[2], h[3]);
                *(u32x2*)(H + (size_t)r * D + 256 * j + 4 * lane) = w; }
        }
    }
}

__device__ __forceinline__ void gla_gate_phase(const Args& a, int gw, int ngw, int lane, int li) {
    const float* OG = (const float*)(a.ws + WS_OG); const bf16* QK = (const bf16*)(a.ws + WS_QK); bf16* AO = (bf16*)(a.ws + WS_AO);
    const float* gh = a.in[IN_GHEAD] + (size_t)li * 512;
    for (int r = gw; r < T; r += ngw) {
        f32x4 o[8];
#pragma unroll
        for (int j = 0; j < 8; ++j) {
            if (OG_BF16) { const bf16* og = (const bf16*)OG; const u32x2 p0 = *(const u32x2*)(og + (size_t)r * D + 256 * j + 4 * lane), p1 = *(const u32x2*)(og + (size_t)T * D + (size_t)r * D + 256 * j + 4 * lane);
                o[j] = (f32x4){bflo(p0.x) + bflo(p1.x), bfhi(p0.x) + bfhi(p1.x), bflo(p0.y) + bflo(p1.y), bfhi(p0.y) + bfhi(p1.y)}; }
            else o[j] = *(const f32x4*)(OG + (size_t)r * D + 256 * j + 4 * lane) + *(const f32x4*)(OG + (size_t)T * D + (size_t)r * D + 256 * j + 4 * lane);
        }
#pragma unroll
        for (int hh = 0; hh < 4; ++hh) {
            float ss = 0.f;
#pragma unroll
            for (int jj = 0; jj < 2; ++jj) { const f32x4 v = o[2 * hh + jj]; ss += (v[0] * v[0] + v[1] * v[1]) + (v[2] * v[2] + v[3] * v[3]); }
            const float rinv = rsqrtf(wave_sum(ss) * (1.f / 512.f) + EPS);
#pragma unroll
            for (int jj = 0; jj < 2; ++jj) { const int j = 2 * hh + jj, c = 256 * j + 4 * lane;
                const f32x4 g = *(const f32x4*)(gh + (c & 511));
                const u32x2 gw2 = *(const u32x2*)(QK + (size_t)r * 4096 + 2048 + c);
                const float g0 = bflo(gw2.x), g1 = bfhi(gw2.x), g2 = bflo(gw2.y), g3 = bfhi(gw2.y);
                const f32x4 v = o[j] * rinv * g;
                u32x2 w; w.x = cvtpk(v[0] * silu_f(g0), v[1] * silu_f(g1)); w.y = cvtpk(v[2] * silu_f(g2), v[3] * silu_f(g3));
                *(u32x2*)(AO + (size_t)r * D + c) = w; }
        }
    }
}

template <class E8> __global__ __launch_bounds__(256) void ref_gemm(const bf16* A, const bf16* Bt, int M, int N, int K, E8 E) {
    __shared__ __attribute__((aligned(16))) float As[32][68]; __shared__ __attribute__((aligned(16))) float Bs[32][68];
    const int t = threadIdx.x, m0 = blockIdx.y * 64, n0 = blockIdx.x * 64, lr = t >> 2, lk = (t & 3) * 8, ty = t >> 3, tx = t & 7;
    float acc[2][8];
#pragma unroll
    for (int i = 0; i < 2; ++i)
#pragma unroll
        for (int j = 0; j < 8; ++j) acc[i][j] = 0.f;
    for (int k0 = 0; k0 < K; k0 += 32) {
        const u32x4 av = *(const u32x4*)(A + (size_t)(m0 + lr) * K + k0 + lk), bv = *(const u32x4*)(Bt + (size_t)(n0 + lr) * K + k0 + lk);
        __syncthreads();
        As[lk + 0][lr] = bflo(av.x); As[lk + 1][lr] = bfhi(av.x); As[lk + 2][lr] = bflo(av.y); As[lk + 3][lr] = bfhi(av.y); As[lk + 4][lr] = bflo(av.z); As[lk + 5][lr] = bfhi(av.z); As[lk + 6][lr] = bflo(av.w); As[lk + 7][lr] = bfhi(av.w);
        Bs[lk + 0][lr] = bflo(bv.x); Bs[lk + 1][lr] = bfhi(bv.x); Bs[lk + 2][lr] = bflo(bv.y); Bs[lk + 3][lr] = bfhi(bv.y); Bs[lk + 4][lr] = bflo(bv.z); Bs[lk + 5][lr] = bfhi(bv.z); Bs[lk + 6][lr] = bflo(bv.w); Bs[lk + 7][lr] = bfhi(bv.w);
        __syncthreads();
#pragma unroll 8
        for (int kk = 0; kk < 32; ++kk) {
            const float a0 = As[kk][2 * ty], a1 = As[kk][2 * ty + 1];
            const f32x4 b0 = *(const f32x4*)&Bs[kk][8 * tx], b1 = *(const f32x4*)&Bs[kk][8 * tx + 4];
#pragma unroll
            for (int j = 0; j < 4; ++j) { acc[0][j] += a0 * b0[j]; acc[0][4 + j] += a0 * b1[j]; acc[1][j] += a1 * b0[j]; acc[1][4 + j] += a1 * b1[j]; }
        }
    }
    E.store8(m0 + 2 * ty, n0 + 8 * tx, acc[0]); E.store8(m0 + 2 * ty + 1, n0 + 8 * tx, acc[1]);
}

__global__ __launch_bounds__(128) void ref_attn(Args a, int li) {
    __shared__ float qs[128]; __shared__ float sc[768]; __shared__ float red[4];
    const bf16* QK = (const bf16*)(a.ws + WS_QK); const bf16* VT = (const bf16*)(a.ws + WS_VT); const bf16* CK = (const bf16*)(a.ws + WS_CK); const bf16* CVT = (const bf16*)(a.ws + WS_CVT);
    bf16* AO = (bf16*)(a.ws + WS_AO);
    const int tok = blockIdx.x >> 4, h = blockIdx.x & 15, tid = threadIdx.x;
    qs[tid] = bf2f(QK[((size_t)h * T + tok) * 128 + tid]);
    __syncthreads();
    const bool lat = tok >= T_P; const int nkeys = lat ? 768 : 256;
    const int bs = lat ? (tok - T_P) >> 10 : 0, tt = (tok - T_P) & 1023, r = tt >> 6, cq = tt & 63, row_start = clampi(r - 4, 0, 8), col_start = clampi(cq - 8, 0, 48);
    const float scale = 0.08838834764831845f;
    float lmax = -3.0e38f;
    for (int key = tid; key < nkeys; key += 128) {
        const bf16* kp; bool valid = true; float bias = 0.f;
        if (!lat) kp = QK + (size_t)T * 2048 + ((size_t)h * T + (tok & ~255) + key) * 128;
        else if (key < 512) { const int kri = key >> 6, ck = key & 63, krow = row_start + kri;
            kp = QK + (size_t)T * 2048 + ((size_t)h * T + T_P + bs * 1024 + krow * 64 + ck) * 128;
            valid = ck >= col_start && ck < col_start + 16;
            const int dr = krow - r + 7, dc = clampi(ck - cq + 15, 0, 30);
            bias = a.in[IN_RPB][(((size_t)li * 16 + h) * 15 + dr) * 31 + dc];
        } else kp = CK + ((((size_t)bs * 2 + li) * 16 + h) * 256 + (key - 512)) * 128;
        float s = 0.f;
        for (int d = 0; d < 128; ++d) s += qs[d] * bf2f(kp[d]);
        s = valid ? s * scale + bias : -1e30f;
        sc[key] = s; lmax = fmaxf(lmax, s);
    }
    for (int o = 32; o >= 1; o >>= 1) lmax = fmaxf(lmax, __shfl_xor(lmax, o));
    if ((tid & 63) == 0) red[tid >> 6] = lmax;
    __syncthreads();
    const float mx = fmaxf(red[0], red[1]);
    float lsum = 0.f;
    for (int key = tid; key < nkeys; key += 128) { const float p = __expf(sc[key] - mx); sc[key] = p; lsum += p; }
    for (int o = 32; o >= 1; o >>= 1) lsum += __shfl_xor(lsum, o);
    if ((tid & 63) == 0) red[2 + (tid >> 6)] = lsum;
    __syncthreads();
    const float inv = 1.f / (red[2] + red[3]);
    float o = 0.f; const int d = tid;
    if (!lat) { const bf16* vp = VT + (size_t)(h * 128 + d) * VTP + (tok & ~255); for (int key = 0; key < 256; ++key) o += sc[key] * bf2f(vp[key]); }
    else {
        const bf16* vp = VT + (size_t)(h * 128 + d) * VTP + T_P + bs * 1024 + row_start * 64; for (int key = 0; key < 512; ++key) o += sc[key] * bf2f(vp[key]);
        const bf16* cp = CVT + ((((size_t)bs * 2 + li) * 16 + h) * 128 + d) * 256; for (int key = 0; key < 256; ++key) o += sc[512 + key] * bf2f(cp[key]);
    }
    AO[(size_t)tok * D + h * 128 + d] = (bf16)f2bf(o * inv);
}

__device__ __forceinline__ float rope_dim(const bf16* xp, int j, int pos_r, int pos_c) {
    const int half = j >> 7, second = (j >> 6) & 1, i = j & 63;
    const float x1 = bf2f(xp[half * 128 + i]), x2 = bf2f(xp[half * 128 + 64 + i]);
    const float freq = exp2f(-(float)i * (13.287712379549449f / 64.f));
    const float ang = (float)(half ? pos_c : pos_r) * freq;
    float rev = ang * 0.15915494309189535f; rev -= floorf(rev);
    const float sn = __builtin_amdgcn_sinf(rev), cs = __builtin_amdgcn_cosf(rev);
    return second ? (x1 * sn + x2 * cs) : (x1 * cs - x2 * sn);
}
__global__ __launch_bounds__(256) void ref_gla(Args a, int li) {
    __shared__ float red[4][8];
    const bf16* QK = (const bf16*)(a.ws + WS_QK); const bf16* VT = (const bf16*)(a.ws + WS_VT); const float* TLR = (const float*)(a.ws + WS_TLR); float* OG = (float*)(a.ws + WS_OG);
    int u = blockIdx.x; const int dvg = u & 63; u >>= 6; const int dir = u & 1; u >>= 1; const int hh = u & 3; const int seq = u >> 2;
    const int j = threadIdx.x, lane = j & 63, wv = j >> 6;
    const bool lat = seq >= 16; const int tb = lat ? T_P + (seq - 16) * 1024 : seq * 256, L = lat ? 1024 : 256, dv0 = dvg * 8;
    float S[8];
#pragma unroll
    for (int e = 0; e < 8; ++e) S[e] = lat ? a.in[IN_SG][(((((size_t)(seq - 16) * 2 + li) * 2 + dir) * 4 + hh) * 256 + j) * 512 + dv0 + e] : 0.f;
    float w2[16];
#pragma unroll
    for (int r = 0; r < 16; ++r) w2[r] = a.in[IN_WA2][(((size_t)li * 2 + dir) * 16 + r) * 1024 + hh * 256 + j];
    const float bz = a.in[IN_BA][((size_t)li * 2 + dir) * 1024 + hh * 256 + j];
    for (int p = 0; p < L; ++p) {
        const int to = dir ? L - 1 - p : p, tok = tb + to;
        float z = bz;
#pragma unroll
        for (int r = 0; r < 16; ++r) z += TLR[(size_t)tok * 32 + dir * 16 + r] * w2[r];
        const float dec = __expf(logsigmoid_f(z) * (1.f / 16.f));
        float qv, kv;
        const bf16* qp = QK + (size_t)tok * 4096 + hh * 256; const bf16* kp = qp + 1024;
        if (lat) { qv = rope_dim(qp, j, to >> 6, to & 63); kv = rope_dim(kp, j, to >> 6, to & 63); } else { qv = bf2f(qp[j]); kv = bf2f(kp[j]); }
        qv *= 0.0625f;
        float pr[8];
#pragma unroll
        for (int e = 0; e < 8; ++e) { const float v = bf2f(VT[(size_t)(hh * 512 + dv0 + e) * VTP + tok]); S[e] = dec * S[e] + kv * v; pr[e] = qv * S[e]; }
#pragma unroll
        for (int e = 0; e < 8; ++e) { float s = pr[e]; for (int o = 32; o >= 1; o >>= 1) s += __shfl_xor(s, o); pr[e] = s; }
        __syncthreads();
        if (lane == 0) {
#pragma unroll
            for (int e = 0; e < 8; ++e) red[wv][e] = pr[e]; }
        __syncthreads();
        if (j < 8) OG[(size_t)dir * T * D + (size_t)tok * D + hh * 512 + dv0 + j] = (red[0][j] + red[1][j]) + (red[2][j] + red[3][j]);
    }
    if (!lat) {
#pragma unroll
        for (int e = 0; e < 8; ++e) a.out[OUT_GLA + (((((size_t)seq * 2 + li) * 2 + dir) * 4 + hh) * 256 + j) * 512 + dv0 + e] = S[e];
    }
}

#define MFMA16(a, b, c) __builtin_amdgcn_mfma_f32_16x16x32_bf16((a), (b), (c), 0, 0, 0)
struct AttState { f32x4 o[8]; float m, l; };

struct AttFrags { bf16x8 kf[2][4]; bf16x8 vf[8]; };
constexpr int AT_KP = 136, AT_VP = 72, AT_KB = 64 * AT_KP * 2  , AT_VB = 128 * AT_VP * 2  , AT_STAGE = AT_KB + AT_VB  , AT_RP = 2 * AT_STAGE  ;
struct AttSrc { const bf16* kb; const bf16* vb; int vstride; };

__device__ __forceinline__ void attn_half(AttState& st, const bf16x8 (&qf)[4], LAS unsigned char* lds, unsigned kfo, unsigned vfo, int kg, int lat, int rprow, int ck0, int qcol, int col_start) {
    const float SC = 0.08838834764831845f * LOG2E;
    AttFrags f;
#pragma unroll
    for (int s = 0; s < 2; ++s)
#pragma unroll
        for (int c = 0; c < 4; ++c) f.kf[s][c] = *(const LAS bf16x8*)(lds + kfo + s * (4 * AT_KP * 2) + c * 64);
#pragma unroll
    for (int dt = 0; dt < 8; ++dt) f.vf[dt] = *(const LAS bf16x8*)(lds + vfo + dt * (16 * AT_VP * 2));
    f32x4 sa[2];
#pragma unroll
    for (int s = 0; s < 2; ++s) { f32x4 acc = {0.f, 0.f, 0.f, 0.f};
#pragma unroll
        for (int c = 0; c < 4; ++c) acc = MFMA16(f.kf[s][c], qf[c], acc);
        sa[s] = acc; }
    const LAS float* rp = (const LAS float*)(lds + AT_RP);
    float mx = -1e30f; float v[8];
#pragma unroll
    for (int e = 0; e < 8; ++e) { const int ck = ck0 + 8 * kg + e; const bool valid = !lat || (ck >= col_start && ck < col_start + 16);
        const float b = lat ? rp[rprow * 32 + clampi(ck - qcol + 15, 0, 30)] * LOG2E : 0.f;
        v[e] = valid ? sa[e >> 2][e & 3] * SC + b : -1e30f; mx = fmaxf(mx, v[e]); }
    mx = fmaxf(mx, __shfl_xor(mx, 16)); mx = fmaxf(mx, __shfl_xor(mx, 32));
    const float mn = fmaxf(st.m, mx), alpha = __builtin_amdgcn_exp2f(st.m - mn);
    float ps = 0.f; float p[8];
#pragma unroll
    for (int e = 0; e < 8; ++e) { const float ex = __builtin_amdgcn_exp2f(v[e] - mn); p[e] = v[e] > -1e29f ? ex : 0.f; ps += p[e]; }
    u32x4 w; w.x = cvtpk(p[0], p[1]); w.y = cvtpk(p[2], p[3]); w.z = cvtpk(p[4], p[5]); w.w = cvtpk(p[6], p[7]);
    const bf16x8 pf = __builtin_bit_cast(bf16x8, w);
    ps += __shfl_xor(ps, 16); ps += __shfl_xor(ps, 32);
    st.l = st.l * alpha + ps; st.m = mn;
#pragma unroll
    for (int dt = 0; dt < 8; ++dt) st.o[dt] = MFMA16(f.vf[dt], pf, st.o[dt] * alpha);
}

__device__ __forceinline__ void attn_phase(const Args& a, LAS unsigned char* lds, int bid, int G, int tid, int li, int ulo = 0, int uhi = 768) {
    const bf16* QK = (const bf16*)(a.ws + WS_QK); const bf16* VT = (const bf16*)(a.ws + WS_VT); const bf16* CK = (const bf16*)(a.ws + WS_CK); const bf16* CVT = (const bf16*)(a.ws + WS_CVT);
    const bf16* KH = QK + (size_t)T * 2048;
    bf16* AO = (bf16*)(a.ws + WS_AO);
    const int lane = tid & 63, wave = __builtin_amdgcn_readfirstlane(tid >> 6), ln = lane & 15, kg = lane >> 4;
    unsigned kst = (unsigned)((tid >> 4) * AT_KP * 2 + (tid & 15) * 16), vst = (unsigned)AT_KB + (unsigned)((tid >> 3) * AT_VP * 2 + (tid & 7) * 16);
    unsigned kfo = (unsigned)((8 * (ln >> 2) + (ln & 3)) * AT_KP * 2 + kg * 16), vfo = (unsigned)AT_KB + (unsigned)(ln * AT_VP * 2 + kg * 16);
    asm volatile("" : "+v"(kst), "+v"(vst), "+v"(kfo), "+v"(vfo));
    for (int u = ulo + bid; u < uhi; u += G) {
        int h, tq0;
        const bool lat = u >= 512;
        int b = 0, bs = 0, rp2 = 0;
        if (!lat) { b = u >> 5; h = (u >> 1) & 15; tq0 = b * 256 + (u & 1) * 128 + 16 * wave; }
        else { const int v = u - 512; bs = v >> 7; h = (v >> 3) & 15; rp2 = 2 * (v & 7); tq0 = T_P + bs * 1024 + (rp2 + (wave >> 2)) * 64 + 16 * (wave & 3); }
        const int r = rp2 + (wave >> 2);
        bf16x8 qf[4];
#pragma unroll
        for (int c = 0; c < 4; ++c) qf[c] = *(const bf16x8*)(QK + ((size_t)h * T + tq0 + ln) * 128 + 32 * c + 8 * kg);
        AttState st;
#pragma unroll
        for (int dt = 0; dt < 8; ++dt) st.o[dt] = (f32x4){0.f, 0.f, 0.f, 0.f};
        st.m = -1e30f; st.l = 0.f;
        const int cq = wave & 3, row_start = clampi(r - 4, 0, 8), qcol = 16 * cq + ln, col_start = clampi(qcol - 8, 0, 48);
        const int h0 = cq == 3 ? 1 : 0, h1 = cq == 0 ? 1 : 2;
        const int rs0 = clampi(rp2 - 4, 0, 8), nlat = lat ? clampi(rp2 + 1 - 4, 0, 8) + 8 - rs0 : 0, ntile = nlat + 4;
        const size_t cm = ((size_t)bs * 2 + li) * 16 + h;
        auto src_of = [&](int j) -> AttSrc {
            AttSrc t;
            if (!lat) { const int tb = b * 256 + 64 * j; t.kb = KH + ((size_t)h * T + tb) * 128; t.vb = VT + (size_t)(h * 128) * VTP + tb; t.vstride = VTP; }
            else if (j < nlat) { const int tb = T_P + bs * 1024 + (rs0 + j) * 64; t.kb = KH + ((size_t)h * T + tb) * 128; t.vb = VT + (size_t)(h * 128) * VTP + tb; t.vstride = VTP; }
            else { const int kt = j - nlat; t.kb = CK + (cm * 256 + 64 * kt) * 128; t.vb = CVT + cm * 128 * 256 + 64 * kt; t.vstride = 256; }
            return t;
        };
        u32x4 sk[2], sv[2];
        auto stage_load = [&](int j) { const AttSrc t = src_of(j);
#pragma unroll
            for (int q = 0; q < 2; ++q) { sk[q] = *(const u32x4*)((const char*)t.kb + (size_t)(tid + 512 * q) * 16);
                sv[q] = *(const u32x4*)((const char*)t.vb + ((size_t)((tid >> 3) + 64 * q) * t.vstride) * 2 + (tid & 7) * 16); } };
        auto stage_store = [&](int buf) {
#pragma unroll
            for (int q = 0; q < 2; ++q) { *(LAS u32x4*)(lds + buf * AT_STAGE + kst + q * (32 * AT_KP * 2)) = sk[q]; *(LAS u32x4*)(lds + buf * AT_STAGE + vst + q * (64 * AT_VP * 2)) = sv[q]; } };
        __syncthreads();
        if (lat && tid < 15 * 31) { const int dr = tid / 31, dc = tid - dr * 31; ((LAS float*)(lds + AT_RP))[dr * 32 + dc] = a.in[IN_RPB][((size_t)li * 16 + h) * 15 * 31 + tid]; }
        stage_load(0); stage_store(0);
        __syncthreads();
#pragma unroll 1
        for (int j = 0; j < ntile; ++j) {
            const int buf = j & 1;
            if (j + 1 < ntile) stage_load(j + 1);
            const bool islat = lat && j < nlat; const int krow = rs0 + j;
            const bool act = !islat || (krow >= row_start && krow < row_start + 8);
            if (act) {
                const int f0 = islat ? h0 : 0, f1 = islat ? h1 : 2;
                for (int hf = f0; hf < f1; ++hf)
                    attn_half(st, qf, lds, buf * AT_STAGE + kfo + hf * (32 * AT_KP * 2), buf * AT_STAGE + vfo + hf * 64, kg, islat, krow - r + 7, 32 * hf, qcol, col_start);
            }
            if (j + 1 < ntile) stage_store(buf ^ 1);
            __syncthreads();
        }
        const float inv = 1.f / st.l;
        bf16* op = AO + (size_t)(tq0 + ln) * D + h * 128 + 4 * kg;
#pragma unroll
        for (int dt = 0; dt < 8; ++dt) { const f32x4 o = st.o[dt] * inv; u32x2 w; w.x = cvtpk(o[0], o[1]); w.y = cvtpk(o[2], o[3]); *(u32x2*)(op + 16 * dt) = w; }
    }
}

constexpr int GL_QD = 0, GL_KLT = 33792, GL_P = 70656, GL_DEC = 79872, GL_IMG = 80896, GL_KD = 80896, GL_GT = 114688;
constexpr int GL_QS = 264, GL_KLS = 72, GL_PS = 72;
constexpr size_t WS_GIMG = WS_HID;
#define LDSP(T_, off) ((LAS T_*)(lds + (off)))
__device__ __forceinline__ int gla_img_index(int seq, int nc, int hh, int dir) { const int cb = seq < 16 ? 4 * seq : 64 + 16 * (seq - 16); return ((cb + nc) * 4 + hh) * 2 + dir; }

__device__ __forceinline__ void gla_prep_unit(const Args& a, LAS unsigned char* lds, int tid, int li, int seq, int nc, int hh, int dir) {
    const bf16* QK = (const bf16*)(a.ws + WS_QK); const float* TLR = (const float*)(a.ws + WS_TLR);
    const int lane = tid & 63, wave = __builtin_amdgcn_readfirstlane(tid >> 6), ln = lane & 15, kg = lane >> 4;
    const bool lat = seq >= 16;
    const int tok0 = (lat ? T_P + (seq - 16) * 1024 : seq * 256) + nc * 64;
    const int half = lane >> 5, i0 = 2 * (lane & 31), ca = half * 128 + i0;
    unsigned la_w = (unsigned)(8 * wave * GL_QS + ca) * 2u;
    unsigned la_klt = (unsigned)GL_KLT + (unsigned)(ca * GL_KLS + 8 * wave) * 2u;
    unsigned la_gt = (unsigned)GL_GT + (unsigned)ca * 4u;
    unsigned la_dec = (unsigned)GL_DEC + (unsigned)ca * 4u;
    unsigned la_fr = (unsigned)(ln * GL_QS + 8 * kg) * 2u;
    unsigned la_pw = (unsigned)GL_P + (unsigned)(ln * GL_PS + 4 * kg) * 2u;
    asm volatile("" : "+v"(la_w), "+v"(la_klt), "+v"(la_gt), "+v"(la_dec), "+v"(la_fr), "+v"(la_pw));
    const float* w2p = a.in[IN_WA2] + ((size_t)li * 2 + dir) * 16 * 1024 + hh * 256 + ca;
    const float* bap = a.in[IN_BA] + ((size_t)li * 2 + dir) * 1024 + hh * 256 + ca;
    const float bz0 = bap[0], bz1 = bap[1], bz2 = bap[64], bz3 = bap[65];
    const float fr0 = exp2f(-(float)i0 * (13.287712379549449f / 64.f)), fr1 = exp2f(-(float)(i0 + 1) * (13.287712379549449f / 64.f));
    float cum[8][4];
    {
#pragma unroll
        for (int t = 0; t < 8; ++t) { cum[t][0] = bz0; cum[t][1] = bz1; cum[t][2] = bz2; cum[t][3] = bz3; }
        const float* wp = w2p; const float* tp = TLR + (size_t)(tok0 + 8 * wave) * 32 + dir * 16;
#pragma unroll 1
        for (int r4 = 0; r4 < 4; ++r4, tp += 4) {
            f32x2 wa[4], wb[4];
#pragma unroll
            for (int rr = 0; rr < 4; ++rr, wp += 1024) { wa[rr] = *(const f32x2*)wp; wb[rr] = *(const f32x2*)(wp + 64); }
#pragma unroll
            for (int t = 0; t < 8; ++t) { const f32x4 tl = *(const f32x4*)(tp + t * 32);
#pragma unroll
                for (int rr = 0; rr < 4; ++rr) { cum[t][0] += tl[rr] * wa[rr][0]; cum[t][1] += tl[rr] * wa[rr][1]; cum[t][2] += tl[rr] * wb[rr][0]; cum[t][3] += tl[rr] * wb[rr][1]; } }
        }
        float run[4] = {0.f, 0.f, 0.f, 0.f};
        if (dir == 0) {
#pragma unroll
            for (int t = 0; t < 8; ++t)
#pragma unroll
                for (int e = 0; e < 4; ++e) { run[e] += logsigmoid_f(cum[t][e]) * (1.f / 16.f); cum[t][e] = run[e]; }
        } else {
#pragma unroll
            for (int t = 7; t >= 0; --t)
#pragma unroll
                for (int e = 0; e < 4; ++e) { run[e] += logsigmoid_f(cum[t][e]) * (1.f / 16.f); cum[t][e] = run[e]; }
        }
        *LDSP(f32x2, la_gt + wave * 1024) = (f32x2){run[0], run[1]}; *LDSP(f32x2, la_gt + wave * 1024 + 256) = (f32x2){run[2], run[3]};
    }
    __syncthreads();
    {
        float pre[4] = {0.f, 0.f, 0.f, 0.f}, tot[4] = {0.f, 0.f, 0.f, 0.f};
#pragma unroll
        for (int g = 0; g < 8; ++g) { const f32x2 x = *LDSP(f32x2, la_gt + g * 1024), y = *LDSP(f32x2, la_gt + g * 1024 + 256);
            const bool before = dir ? (g > wave) : (g < wave);
            tot[0] += x[0]; tot[1] += x[1]; tot[2] += y[0]; tot[3] += y[1];
            if (before) { pre[0] += x[0]; pre[1] += x[1]; pre[2] += y[0]; pre[3] += y[1]; } }
        float dtot[4];
#pragma unroll
        for (int e = 0; e < 4; ++e) dtot[e] = __expf(tot[e]);
        if (wave == 0) { *LDSP(f32x2, la_dec) = (f32x2){dtot[0], dtot[1]}; *LDSP(f32x2, la_dec + 256) = (f32x2){dtot[2], dtot[3]}; }
        unsigned klp[4][4];
        float klh[4] = {0.f, 0.f, 0.f, 0.f};
        const bf16* qp = QK + (size_t)(tok0 + 8 * wave) * 4096 + hh * 256 + ca;
#pragma unroll
        for (int t = 0; t < 8; ++t, qp += 4096) {
            const unsigned qa = *(const unsigned*)(qp), qb = *(const unsigned*)(qp + 64), ka = *(const unsigned*)(qp + 1024), kb2 = *(const unsigned*)(qp + 1024 + 64);
            float q[4] = {bflo(qa), bfhi(qa), bflo(qb), bfhi(qb)}, k[4] = {bflo(ka), bfhi(ka), bflo(kb2), bfhi(kb2)};
            if (lat) {
                const float pos = (float)(half ? 8 * wave + t : nc);
                float r0 = pos * fr0 * 0.15915494309189535f, r1 = pos * fr1 * 0.15915494309189535f; r0 -= floorf(r0); r1 -= floorf(r1);
                const float s0 = __builtin_amdgcn_sinf(r0), c0 = __builtin_amdgcn_cosf(r0), s1 = __builtin_amdgcn_sinf(r1), c1 = __builtin_amdgcn_cosf(r1);
                const float q0 = q[0] * c0 - q[2] * s0, q2 = q[0] * s0 + q[2] * c0, q1 = q[1] * c1 - q[3] * s1, q3 = q[1] * s1 + q[3] * c1;
                const float k0 = k[0] * c0 - k[2] * s0, k2 = k[0] * s0 + k[2] * c0, k1 = k[1] * c1 - k[3] * s1, k3 = k[1] * s1 + k[3] * c1;
                q[0] = q0; q[1] = q1; q[2] = q2; q[3] = q3; k[0] = k0; k[1] = k1; k[2] = k2; k[3] = k3;
            }
            float qd[4], kd[4];
#pragma unroll
            for (int e = 0; e < 4; ++e) { const float cm = pre[e] + cum[t][e], ec = __expf(cm), ei = __builtin_amdgcn_rcpf(ec); qd[e] = q[e] * 0.0625f * ec; kd[e] = k[e] * ei;
                const float kl = kd[e] * dtot[e]; if (t & 1) klp[e][t >> 1] = cvtpk(klh[e], kl); else klh[e] = kl; }
            *LDSP(unsigned, GL_QD + la_w + t * (GL_QS * 2)) = cvtpk(qd[0], qd[1]); *LDSP(unsigned, GL_QD + la_w + t * (GL_QS * 2) + 128) = cvtpk(qd[2], qd[3]);
            *LDSP(unsigned, GL_KD + la_w + t * (GL_QS * 2)) = cvtpk(kd[0], kd[1]); *LDSP(unsigned, GL_KD + la_w + t * (GL_QS * 2) + 128) = cvtpk(kd[2], kd[3]);
        }
#pragma unroll
        for (int e = 0; e < 4; ++e) { const int coff = ((e < 2 ? 0 : 64) + (e & 1)) * GL_KLS * 2;
            u32x4 w; w.x = klp[e][0]; w.y = klp[e][1]; w.z = klp[e][2]; w.w = klp[e][3];
            *LDSP(u32x4, la_klt + coff) = w; }
    }
    __syncthreads();
#pragma unroll
    for (int j = 0; j < 2; ++j) { const int idx = 2 * wave + j, sb = idx >> 2, tbk = idx & 3;
        f32x4 acc = {0.f, 0.f, 0.f, 0.f};
        const unsigned ka_ = GL_KD + la_fr + sb * (16 * GL_QS * 2), qa_ = GL_QD + la_fr + tbk * (16 * GL_QS * 2);
#pragma unroll
        for (int c = 0; c < 8; ++c) { const bf16x8 af = *LDSP(const bf16x8, ka_ + 64 * c), bfr = *LDSP(const bf16x8, qa_ + 64 * c); acc = MFMA16(af, bfr, acc); }
        const int t = 16 * tbk + ln;
        float pv[4];
#pragma unroll
        for (int i = 0; i < 4; ++i) { const int s = 16 * sb + 4 * kg + i; const bool keep = dir ? (s >= t) : (s <= t); pv[i] = keep ? acc[i] : 0.f; }
        u32x2 w; w.x = cvtpk(pv[0], pv[1]); w.y = cvtpk(pv[2], pv[3]);
        *LDSP(u32x2, la_pw + tbk * (16 * GL_PS * 2) + sb * 32) = w; }
    __syncthreads();
    {
        unsigned char* img = a.ws + WS_GIMG + (size_t)gla_img_index(seq, nc, hh, dir) * GL_IMG;
#pragma unroll
        for (int j = 0; j < 10; ++j) { const int pc = tid + 512 * j; if (pc < GL_IMG / 16) *(u32x4*)(img + (size_t)pc * 16) = *LDSP(const u32x4, pc * 16); }
    }
    __syncthreads();
}

__device__ __forceinline__ void gla_prep_phase(const Args& a, LAS unsigned char* lds, int bid, int G, int tid, int li) {
    for (int u = bid; u < 768; u += G) { const int dir = u & 1, hh = (u >> 1) & 3, cpos = u >> 3;
        const int seq = cpos < 64 ? cpos >> 2 : 16 + ((cpos - 64) >> 4), nc = cpos < 64 ? cpos & 3 : (cpos - 64) & 15;
        gla_prep_unit(a, lds, tid, li, seq, nc, hh, dir); }
}

__device__ __forceinline__ void gla_scan_unit(const Args& a, LAS unsigned char* lds, int tid, int li, int seq, int hh, int dir, int dvs) {
    const bf16* VT = (const bf16*)(a.ws + WS_VT); float* OG = (float*)(a.ws + WS_OG);
    const int lane = tid & 63, wave = __builtin_amdgcn_readfirstlane(tid >> 6), ln = lane & 15, kg = lane >> 4;
    const bool lat = seq >= 16;
    const int tb = lat ? T_P + (seq - 16) * 1024 : seq * 256, nch = lat ? 16 : 4;
    unsigned la_fr = (unsigned)GL_QD + (unsigned)(ln * GL_QS + 8 * kg) * 2u;
    unsigned la_p = (unsigned)GL_P + (unsigned)(ln * GL_PS + 8 * kg) * 2u;
    unsigned la_kr = (unsigned)GL_KLT + (unsigned)((8 * (ln >> 2) + (ln & 3)) * GL_KLS + 8 * kg) * 2u;
    unsigned la_dr = (unsigned)GL_DEC + (unsigned)(8 * kg) * 4u;
    unsigned la_cp = (unsigned)tid * 16u;
    asm volatile("" : "+v"(la_fr), "+v"(la_p), "+v"(la_kr), "+v"(la_dr), "+v"(la_cp));
    const int dvcol = dvs * 128 + 16 * wave + ln;
    f32x4 Sacc[8][2];
    if (lat) { const float* sp = a.in[IN_SG] + ((((size_t)(seq - 16) * 2 + li) * 2 + dir) * 4 + hh) * 256 * 512 + dvcol + (size_t)(8 * kg) * 512;
#pragma unroll
        for (int c = 0; c < 8; ++c)
#pragma unroll
            for (int s = 0; s < 2; ++s)
#pragma unroll
                for (int i = 0; i < 4; ++i) Sacc[c][s][i] = sp[(size_t)(32 * c + 4 * s + i) * 512];
    } else {
#pragma unroll
        for (int c = 0; c < 8; ++c)
#pragma unroll
            for (int s = 0; s < 2; ++s) Sacc[c][s] = (f32x4){0.f, 0.f, 0.f, 0.f};
    }
    const bf16* vrow = VT + (size_t)(hh * 512 + dvcol) * VTP + 8 * kg;
    const unsigned char* imgs = a.ws + WS_GIMG;
    u32x4 stg[10]; bf16x8 vfn[2];
    { const int nc = dir ? nch - 1 : 0; const unsigned char* img = imgs + (size_t)gla_img_index(seq, nc, hh, dir) * GL_IMG + la_cp;
#pragma unroll
      for (int j = 0; j < 10; ++j) if (j < 9 || tid < (GL_IMG / 16 - 9 * 512)) stg[j] = *(const u32x4*)(img + (size_t)j * 8192);
#pragma unroll
      for (int c = 0; c < 2; ++c) vfn[c] = *(const bf16x8*)(vrow + tb + nc * 64 + 32 * c); }
#pragma unroll 1
    for (int p = 0; p < nch; ++p) {
        const int nc = dir ? nch - 1 - p : p, tok0 = tb + nc * 64;
#pragma unroll
        for (int j = 0; j < 10; ++j) if (j < 9 || tid < (GL_IMG / 16 - 9 * 512)) *LDSP(u32x4, la_cp + j * 8192) = stg[j];
        bf16x8 vf[2] = {vfn[0], vfn[1]};
        __syncthreads();
        if (p + 1 < nch) { const int nn = dir ? nch - 2 - p : p + 1; const unsigned char* img = imgs + (size_t)gla_img_index(seq, nn, hh, dir) * GL_IMG + la_cp;
#pragma unroll
            for (int j = 0; j < 10; ++j) if (j < 9 || tid < (GL_IMG / 16 - 9 * 512)) stg[j] = *(const u32x4*)(img + (size_t)j * 8192);
#pragma unroll
            for (int c = 0; c < 2; ++c) vfn[c] = *(const bf16x8*)(vrow + tb + nn * 64 + 32 * c); }
        {
            bf16x8 sf[8];
#pragma unroll
            for (int c = 0; c < 8; ++c) { u32x4 w; w.x = cvtpk(Sacc[c][0][0], Sacc[c][0][1]); w.y = cvtpk(Sacc[c][0][2], Sacc[c][0][3]); w.z = cvtpk(Sacc[c][1][0], Sacc[c][1][1]); w.w = cvtpk(Sacc[c][1][2], Sacc[c][1][3]);
                sf[c] = __builtin_bit_cast(bf16x8, w); }
            const size_t ogi = (size_t)dir * T * D + (size_t)(tok0 + ln) * D + hh * 512 + dvs * 128 + 16 * wave + 4 * kg;
#pragma unroll
            for (int tt = 0; tt < 4; ++tt) {
                f32x4 o = {0.f, 0.f, 0.f, 0.f};
#pragma unroll
                for (int c = 0; c < 2; ++c) { const bf16x8 pf = *LDSP(const bf16x8, la_p + tt * (16 * GL_PS * 2) + 64 * c); o = MFMA16(vf[c], pf, o); }
#pragma unroll
                for (int c = 0; c < 8; ++c) { const bf16x8 qf = *LDSP(const bf16x8, la_fr + tt * (16 * GL_QS * 2) + 64 * c); o = MFMA16(sf[c], qf, o); }
                if (OG_BF16) { u32x2 w; w.x = cvtpk(o[0], o[1]); w.y = cvtpk(o[2], o[3]); *(u32x2*)((bf16*)OG + ogi + (size_t)(16 * tt) * D) = w; }
                else *(f32x4*)(OG + ogi + (size_t)(16 * tt) * D) = o;
            }
#pragma unroll
            for (int c = 0; c < 8; ++c)
#pragma unroll
                for (int s = 0; s < 2; ++s) {
                    const f32x4 dc = *LDSP(const f32x4, la_dr + (32 * c + 4 * s) * 4);
                    f32x4 acc = Sacc[c][s] * dc;
#pragma unroll
                    for (int c2 = 0; c2 < 2; ++c2) { const bf16x8 kf = *LDSP(const bf16x8, la_kr + (32 * c + 4 * s) * (GL_KLS * 2) + 64 * c2); acc = MFMA16(kf, vf[c2], acc); }
                    Sacc[c][s] = acc;
                }
        }
        __syncthreads();
    }
    if (!lat) { float* sp = a.out + OUT_GLA + ((((size_t)seq * 2 + li) * 2 + dir) * 4 + hh) * 256 * 512 + dvcol + (size_t)(8 * kg) * 512;
#pragma unroll
        for (int c = 0; c < 8; ++c)
#pragma unroll
            for (int s = 0; s < 2; ++s)
#pragma unroll
                for (int i = 0; i < 4; ++i) sp[(size_t)(32 * c + 4 * s + i) * 512] = Sacc[c][s][i];
    }
}

__device__ __forceinline__ void gla_scan_phase(const Args& a, LAS unsigned char* lds, int bid, int G, int tid, int li) {
    if (G > 64) {
        if (bid < 64) { const int u = bid; gla_scan_unit(a, lds, tid, li, 16 + (u >> 5), (u >> 3) & 3, (u >> 2) & 1, u & 3); }
        else for (int u = bid - 64; u < 512; u += G - 64) gla_scan_unit(a, lds, tid, li, u >> 5, (u >> 3) & 3, (u >> 2) & 1, u & 3);
    } else {
        for (int u = bid; u < 576; u += G) gla_scan_unit(a, lds, tid, li, u >> 5, (u >> 3) & 3, (u >> 2) & 1, u & 3);
    }
}
#undef LDSP

#ifndef PROBE_DOUBLE
#define PROBE_DOUBLE 0
#endif
#ifndef STAGGER
#define STAGGER 0
#endif
#ifndef W2_SPLITK
#define W2_SPLITK 0
#endif
constexpr int LDS_BYTES = 147456;
constexpr int MISC_OFF = 131072 + 320;

__global__ void __launch_bounds__(512, 2) mega_fwd(Args a) {
    extern __shared__ __attribute__((aligned(16))) unsigned char lds_raw[];
    LAS unsigned char* lds = (LAS unsigned char*)lds_raw;
    volatile LAS unsigned* MISC = (volatile LAS unsigned*)(lds + MISC_OFF);
    const int G = gridDim.x, bid = blockIdx.x;
    for (int u = threadIdx.x; u < (LDS_BYTES - 131072) / 4; u += 512) ((LAS unsigned*)(lds + 131072))[u] = 0u;
    __syncthreads();
    unsigned* ctl = (unsigned*)(a.ws + WS_CTL);
    const int lo = a.ph_lo, hi = a.ph_hi;
    XcdBarrier bar = xcd_barrier_post(ctl + CW_BAR + lo * XCD_BAR_WORDS, MISC + 8);
#define IN(k) (lo <= (k) && (k) < hi)
#define SEAM(k) do { if (IN(k) && IN((k) + 1)) { xcd_barrier(bar); if (PROBE_DOUBLE & 16) xcd_barrier(bar); } } while (0)
    const int ngw = G * 8;
#define LANEVARS int tid = threadIdx.x; asm volatile("" : "+v"(tid)); const int lane = tid & 63, wave = __builtin_amdgcn_readfirstlane(tid >> 6), gw = bid * 8 + wave; (void)lane; (void)gw
    unsigned char* ws = a.ws;
    const float* MOD = (const float*)(ws + WS_MOD);
    const float* NG = a.in[IN_NORMG];
    bf16* H = (bf16*)(ws + WS_H); bf16* QK = (bf16*)(ws + WS_QK); bf16* VT = (bf16*)(ws + WS_VT); bf16* AO = (bf16*)(ws + WS_AO); bf16* HID = (bf16*)(ws + WS_HID);
    float* Y = (float*)(ws + WS_Y); float* TLR = (float*)(ws + WS_TLR);

    if (IN(PH_PRO)) { LANEVARS; prologue_phase(a, lds, bid, G, tid); if (PROBE_DOUBLE & 8) { __syncthreads(); prologue_phase(a, lds, bid, G, tid); } }
    SEAM(PH_PRO);
    if (IN(PH_R0)) { LANEVARS; row_phase<true, false, true>(a, gw, ngw, lane, nullptr, nullptr, 0, NG + 0 * D, MOD, 0, 1); }
    SEAM(PH_R0);

    for (int l = 0; l < NL; ++l) {
        const int pb = PH_L0 + l * PH_PER_LAYER, li = l >> 1;
        const bool gla = l & 1;
        const bf16* Wmix = (const bf16*)(ws + WS_WMIX) + (size_t)l * NMIX * D;
        const float* MODl = MOD + (size_t)l * 3 * 12288;
        for (int rep = 0; rep < ((PROBE_DOUBLE & (1 | 2048)) ? 2 : 1); ++rep)
        if (IN(pb + LP_MIX)) {
            if (!gla) {
                { pg8::Gemm g{H, Wmix, T, NQK_NA, D}; pg8::StaticOrder S; S.init(T, NQK_NA, G, bid);
                  EpiWrap<E8NaQK> E{{QK, a.out + OUT_NK, li}}; pg8::gemm_phase<EpiWrap<E8NaQK>, pg8::StaticOrder, false, true>(lds, g, S, E); }
                { pg8::Gemm g{Wmix + (size_t)NQK_NA * D, H, 2048, T, D}; pg8::StaticOrder S; S.init(2048, T, G, (bid + 128) % G);
                  EpiWrap<E8VT> E{{VT, a.out + OUT_NV, li}}; pg8::gemm_phase<EpiWrap<E8VT>, pg8::StaticOrder, false, true>(lds, g, S, E); }
            } else {
                { pg8::Gemm g{H, Wmix, T, NQK_GLA, D}; pg8::StaticOrder S; S.init(T, NQK_GLA, G, bid);
                  EpiWrap<E8GlaQKG> E{{QK, TLR}}; pg8::gemm_phase<EpiWrap<E8GlaQKG>, pg8::StaticOrder, false, true>(lds, g, S, E); }
                { pg8::Gemm g{Wmix + (size_t)NQK_GLA * D, H, 2048, T, D}; pg8::StaticOrder S; S.init(2048, T, G, (bid + 104) % G);
                  EpiWrap<E8VT> E{{VT, nullptr, 0}}; pg8::gemm_phase<EpiWrap<E8VT>, pg8::StaticOrder, false, true>(lds, g, S, E); }
            }
        }
        if (IN(pb + LP_MIX) && l + 1 < NL) {
            const int first = gla ? 88 : 64;
            if (G == 256 && bid >= first) { LANEVARS; if (ADA_DEFER) { __syncthreads(); silu_table(a, lds, tid); ada_layer(a, lds, l + 1, bid - first, G - first, tid); } convert_weights(a, lds, l + 1, 0, CV_MIX_END, bid - first, G - first, tid); }
        }
        SEAM(pb + LP_MIX);
        if (IN(pb + LP_CORE)) {
            LANEVARS; if (!gla) { attn_phase(a, lds, bid, G, tid, li); if (PROBE_DOUBLE & 2) attn_phase(a, lds, bid, G, tid, li); if (PROBE_DOUBLE & 64) attn_phase(a, lds, bid, G, tid, li, 0, 512); if (PROBE_DOUBLE & 128) attn_phase(a, lds, bid, G, tid, li, 512, 768); }
            else { gla_prep_phase(a, lds, bid, G, tid, li); if (PROBE_DOUBLE & 32) gla_prep_phase(a, lds, bid, G, tid, li);
                   xcd_barrier(bar);
                   gla_scan_phase(a, lds, bid, G, tid, li); if (PROBE_DOUBLE & 4) gla_scan_phase(a, lds, bid, G, tid, li); }
        }
        SEAM(pb + LP_CORE);
        if (gla) {
            if (IN(pb + LP_GATE)) { LANEVARS; gla_gate_phase(a, gw, ngw, lane, li); }
            SEAM(pb + LP_GATE);
        }
        for (int rep = 0; rep < ((PROBE_DOUBLE & (1 | 1024)) ? 2 : 1); ++rep)
        if (IN(pb + LP_WO)) {
            if (l + 1 < NL && G == 256 && bid >= 192) { LANEVARS; convert_weights(a, lds, l + 1, CV_MIX_END, CV_WO_END, bid - 192, G - 192, tid); }
            pg8::Gemm g{AO, (const bf16*)(ws + WS_WO) + (size_t)l * D * D, T, D, D}; pg8::StaticOrder S; S.init(T, D, G, bid);
            if (Y_BF16) { EpiWrap<E8Bf16> E{{(bf16*)Y, D}}; pg8::gemm_phase<EpiWrap<E8Bf16>, pg8::StaticOrder, false, true>(lds, g, S, E); }
            else { EpiWrap<E8F32> E{{Y, D}}; pg8::gemm_phase<EpiWrap<E8F32>, pg8::StaticOrder, false, true>(lds, g, S, E); }
        }
        SEAM(pb + LP_WO);
        if (IN(pb + LP_ROWMID)) { LANEVARS; row_phase<false, true, true>(a, gw, ngw, lane, NG + ((size_t)l * 4 + 1) * D, MODl, 2, NG + ((size_t)l * 4 + 2) * D, MODl, 3, 4); }
        SEAM(pb + LP_ROWMID);
        for (int rep = 0; rep < ((PROBE_DOUBLE & (1 | 256)) ? 2 : 1); ++rep)
        if (IN(pb + LP_W1)) {
            if (STAGGER) { const int pos = (bid >> 3) & 31; for (int i = 0; i < pos; ++i) __builtin_amdgcn_s_sleep(STAGGER); }
            pg8::Gemm g{H, (const bf16*)(ws + WS_W1) + (size_t)l * FF * D, T, FF, D}; pg8::StaticOrder S; S.init(T, FF, G, bid);
            EpiWrap<E8Relu2> E{{HID, FF}}; pg8::gemm_phase<EpiWrap<E8Relu2>, pg8::StaticOrder, false, true>(lds, g, S, E);
        }
        SEAM(pb + LP_W1);
        for (int rep = 0; rep < ((PROBE_DOUBLE & (1 | 512)) ? 2 : 1); ++rep)
        if (IN(pb + LP_W2)) {
            constexpr int W2_UNITS = (T / 256) * (D / 256);
            if (!W2_SPLITK && l + 1 < NL && G == 256 && bid >= W2_UNITS) { LANEVARS; convert_weights(a, lds, l + 1, CV_WO_END, CV_W2_END, bid - W2_UNITS, G - W2_UNITS, tid); }

            pg8::Gemm g{HID, (const bf16*)(ws + WS_W2) + (size_t)l * D * FF, T, D, FF};
            EpiF32Part E{Y, Y + (size_t)T * D};
            if (G == 256 && W2_SPLITK) { SplitKOrder S{bid}; pg8::gemm_phase<EpiF32Part, SplitKOrder, true, true>(lds, g, S, E); }
            else if (Y_BF16) { pg8::StaticOrder S; S.init(T, D, G, bid); EpiWrap<E8Bf16> E2{{(bf16*)Y, D}}; pg8::gemm_phase<EpiWrap<E8Bf16>, pg8::StaticOrder, false, true>(lds, g, S, E2); }
            else { pg8::StaticOrder S; S.init(T, D, G, bid); pg8::gemm_phase<EpiF32Part, pg8::StaticOrder, false, true>(lds, g, S, E); }
        }
        SEAM(pb + LP_W2);
        if (IN(pb + LP_ROWEND)) {
            LANEVARS;
            if (G == 256 && W2_SPLITK) {
                if (l < NL - 1) row_phase<false, true, true, true>(a, gw, ngw, lane, NG + ((size_t)l * 4 + 3) * D, MODl, 5, NG + ((size_t)(l + 1) * 4 + 0) * D, MODl + 3 * 12288, 0, 1);
                else            row_phase<false, true, false, true>(a, gw, ngw, lane, NG + ((size_t)l * 4 + 3) * D, MODl, 5, nullptr, nullptr, 0, 0);
            } else {
                if (l < NL - 1) row_phase<false, true, true>(a, gw, ngw, lane, NG + ((size_t)l * 4 + 3) * D, MODl, 5, NG + ((size_t)(l + 1) * 4 + 0) * D, MODl + 3 * 12288, 0, 1);
                else            row_phase<false, true, false>(a, gw, ngw, lane, NG + ((size_t)l * 4 + 3) * D, MODl, 5, nullptr, nullptr, 0, 0);
            }
        }
        SEAM(pb + LP_ROWEND);
    }
#undef IN
#undef SEAM
#undef LANEVARS
}

static void launch_range(const Args& base, int lo, int hi, int grid, hipStream_t stream) {
    if (lo >= hi) return;
    Args a = base; a.ph_lo = lo; a.ph_hi = hi;
    hipLaunchKernelGGL(mega_fwd, dim3(grid), dim3(512), LDS_BYTES, stream, a);
    const hipError_t le = hipPeekAtLastError();
    if (le != hipSuccess) fprintf(stderr, "kernel_launch: mega_fwd [%d,%d) failed: %s\n", lo, hi, hipGetErrorName(le));
}
template <class E8> static void launch_ref_gemm(const bf16* A, const bf16* Bt, int M, int N, int K, const E8& E, hipStream_t stream) {
    hipLaunchKernelGGL((ref_gemm<E8>), dim3(N / 64, M / 64), dim3(256), 0, stream, A, Bt, M, N, K, E);
}

extern "C" void kernel_launch(void* const* d_in, const int* in_sizes, int n_in, void* d_out, int out_size, void* d_ws, size_t ws_size, hipStream_t stream) {
    static int grid = 0;
    if (grid == 0) {
        if (n_in != 21 || (size_t)out_size != OUT_TOTAL || ws_size < WS_END) { fprintf(stderr, "kernel_launch: unexpected shapes (n_in %d out %d ws %zu)\n", n_in, out_size, ws_size); grid = -1; return; }
        int dev = 0, cus = 0, per_cu = 0;
        if (hipGetDevice(&dev) != hipSuccess || hipDeviceGetAttribute(&cus, hipDeviceAttributeMultiprocessorCount, dev) != hipSuccess) { grid = -1; return; }
        if (hipFuncSetAttribute((const void*)mega_fwd, hipFuncAttributeMaxDynamicSharedMemorySize, LDS_BYTES) != hipSuccess) { fprintf(stderr, "kernel_launch: hipFuncSetAttribute failed\n"); grid = -1; return; }
        if (hipOccupancyMaxActiveBlocksPerMultiprocessor(&per_cu, (const void*)mega_fwd, 512, LDS_BYTES) != hipSuccess || per_cu < 1) fprintf(stderr, "kernel_launch: occupancy query says %d\n", per_cu);
        (void)hipGetLastError();
        grid = cus;
    }
    if (grid < 0) return;
    (void)hipMemsetAsync((char*)d_ws + WS_CTL, 0, CTL_ZERO_BYTES, stream);
    Args a{};
    for (int i = 0; i < 21; ++i) a.in[i] = (const float*)d_in[i];
    a.out = (float*)d_out; a.ws = (unsigned char*)d_ws;
#if CFG_ONE_LAUNCH && !CFG_NAIVE_GEMM && !CFG_NAIVE_ATTN && !CFG_NAIVE_GLA
    launch_range(a, 0, NPH, grid, stream);
#else
    unsigned char* ws = (unsigned char*)d_ws;
    bf16* H = (bf16*)(ws + WS_H); bf16* QK = (bf16*)(ws + WS_QK); bf16* VT = (bf16*)(ws + WS_VT); bf16* AO = (bf16*)(ws + WS_AO); bf16* HID = (bf16*)(ws + WS_HID);
    float* Y = (float*)(ws + WS_Y); float* TLR = (float*)(ws + WS_TLR);
    launch_range(a, PH_PRO, PH_PRO + 1, grid, stream);
    launch_range(a, PH_R0, PH_R0 + 1, grid, stream);
    for (int l = 0; l < NL; ++l) {
        const int pb = PH_L0 + l * PH_PER_LAYER, li = l >> 1; const bool gla = l & 1;
        const bf16* Wmix = (const bf16*)(ws + WS_WMIX) + (size_t)l * NMIX * D;
        if (CFG_NAIVE_GEMM) {
            if (!gla) { launch_ref_gemm(H, Wmix, T, NQK_NA, D, E8NaQK{QK, a.out + OUT_NK, li}, stream); launch_ref_gemm(Wmix + (size_t)NQK_NA * D, H, 2048, T, D, E8VT{VT, a.out + OUT_NV, li}, stream); }
            else { launch_ref_gemm(H, Wmix, T, NQK_GLA, D, E8GlaQKG{QK, TLR}, stream); launch_ref_gemm(Wmix + (size_t)NQK_GLA * D, H, 2048, T, D, E8VT{VT, nullptr, 0}, stream); }
        } else launch_range(a, pb + LP_MIX, pb + LP_MIX + 1, grid, stream);
        if (!gla) { if (CFG_NAIVE_ATTN) hipLaunchKernelGGL(ref_attn, dim3(T * 16), dim3(128), 0, stream, a, li); else launch_range(a, pb + LP_CORE, pb + LP_CORE + 1, grid, stream); }
        else { if (CFG_NAIVE_GLA) hipLaunchKernelGGL(ref_gla, dim3(18 * 4 * 2 * 64), dim3(256), 0, stream, a, li); else launch_range(a, pb + LP_CORE, pb + LP_CORE + 1, grid, stream);
               launch_range(a, pb + LP_GATE, pb + LP_GATE + 1, grid, stream); }
        if (CFG_NAIVE_GEMM) launch_ref_gemm(AO, (const bf16*)(ws + WS_WO) + (size_t)l * D * D, T, D, D, E8F32{Y, D}, stream); else launch_range(a, pb + LP_WO, pb + LP_WO + 1, grid, stream);
        launch_range(a, pb + LP_ROWMID, pb + LP_ROWMID + 1, grid, stream);
        if (CFG_NAIVE_GEMM) launch_ref_gemm(H, (const bf16*)(ws + WS_W1) + (size_t)l * FF * D, T, FF, D, E8Relu2{HID, FF}, stream); else launch_range(a, pb + LP_W1, pb + LP_W1 + 1, grid, stream);
        if (CFG_NAIVE_GEMM) launch_ref_gemm(HID, (const bf16*)(ws + WS_W2) + (size_t)l * D * FF, T, D, FF, E8F32{Y, D}, stream); else launch_range(a, pb + LP_W2, pb + LP_W2 + 1, grid, stream);
        launch_range(a, pb + LP_ROWEND, pb + LP_ROWEND + 1, grid, stream);
    }
#endif
}
```

```cpp
#include <hip/hip_runtime.h>
#include <cstdio>
#include <cstdint>

#ifndef CFG_NAIVE_GEMM
#define CFG_NAIVE_GEMM 0
#endif
#ifndef CFG_NAIVE_ATTN
#define CFG_NAIVE_ATTN 0
#endif
#ifndef CFG_NAIVE_GLA
#define CFG_NAIVE_GLA 0
#endif
#ifndef Y_BF16
#define Y_BF16 1
#endif
#ifndef OG_BF16
#define OG_BF16 1
#endif
#ifndef CFG_ONE_LAUNCH
#define CFG_ONE_LAUNCH 1
#endif

#define GAS __attribute__((address_space(1)))
#define LAS __attribute__((address_space(3)))
typedef unsigned short bf16;
typedef float f32x4 __attribute__((ext_vector_type(4)));
typedef float f32x2 __attribute__((ext_vector_type(2)));
typedef short bf16x8 __attribute__((ext_vector_type(8)));
typedef short bf16x4 __attribute__((ext_vector_type(4)));
typedef unsigned u32x4 __attribute__((ext_vector_type(4)));
typedef unsigned u32x2 __attribute__((ext_vector_type(2)));

constexpr int D = 2048, T_P = 4096, T_S = 2048, T = 6144, FF = 8192, NL = 4;
constexpr int NMIX = 6400;
constexpr int NQK_NA = 4096, NQK_GLA = 4352;
constexpr float EPS = 1e-6f;
constexpr float LOG2E = 1.4426950408889634f;

constexpr size_t MiB = 1u << 20;
constexpr size_t WS_CTL = 0, CTL_ZERO_BYTES = 1 * MiB;
constexpr size_t WS_MOD = 1 * MiB;
constexpr size_t WS_WMIX = 2 * MiB;
constexpr size_t WS_WO = 102 * MiB;
constexpr size_t WS_W1 = 134 * MiB;
constexpr size_t WS_W2 = 262 * MiB;
constexpr size_t WS_CK = 390 * MiB;
constexpr size_t WS_CVT = 394 * MiB;
constexpr size_t WS_H = 398 * MiB;
constexpr size_t WS_QK = 422 * MiB;
constexpr int VTP = T + 64;
constexpr size_t WS_VT = 470 * MiB;
constexpr size_t WS_TLR = 496 * MiB;
constexpr size_t WS_AO = 497 * MiB;
constexpr size_t WS_OG = 521 * MiB;
constexpr size_t WS_Y = 617 * MiB;
constexpr size_t WS_HID = 713 * MiB;
constexpr size_t WS_END = 809 * MiB;
constexpr int CW_BAR = 4096;

constexpr size_t OUT_X = 0;
constexpr size_t OUT_NK = 12582912, OUT_NV = 29360128, OUT_GLA = 46137344, OUT_TOTAL = 79691776;

__device__ __forceinline__ unsigned f2bf(float f) { unsigned u = __builtin_bit_cast(unsigned, f); return (u + 0x7fffu + ((u >> 16) & 1u)) >> 16; }
__device__ __forceinline__ unsigned pk2(float lo, float hi) { return f2bf(lo) | (f2bf(hi) << 16); }
__device__ __forceinline__ float bf2f(unsigned short b) { return __builtin_bit_cast(float, ((unsigned)b) << 16); }
__device__ __forceinline__ float bflo(unsigned w) { return __builtin_bit_cast(float, w << 16); }
__device__ __forceinline__ float bfhi(unsigned w) { return __builtin_bit_cast(float, w & 0xffff0000u); }
#define LDS_WAIT() asm volatile("s_waitcnt lgkmcnt(0)" ::: "memory")
#define VM_WAIT() asm volatile("s_waitcnt vmcnt(0)" ::: "memory")

namespace pg8 {
#define PG8_LAS __attribute__((address_space(3)))
typedef unsigned short bf16_t;
typedef short bf16x8 __attribute__((ext_vector_type(8)));
typedef float f32x4 __attribute__((ext_vector_type(4)));
typedef unsigned u32x4 __attribute__((ext_vector_type(4)));
constexpr int BM = 256, BK = 64, HALF = 128, HTB = HALF * BK * 2  , STAGE_BYTES = 8 * HTB, NXCD = 8, WGM = 8;

__host__ __device__ __forceinline__ int lds_byte(int r, int c) { const int st = (r >> 4) * 2 + (c >> 5), rr = r & 15, cc = c & 31, ob = rr * 64 + cc * 2; return st * 1024 + (ob ^ (((ob >> 9) & 1) << 5)); }
__host__ __device__ __forceinline__ void stage_rc(int b, int& R, int& C) { const int st = b / 1024, sb = b % 1024, swz = sb ^ (((sb >> 9) & 1) << 5); R = (st >> 1) * 16 + swz / 64; C = (st & 1) * 32 + (swz % 64) / 2; }
__host__ __device__ __forceinline__ int perm32(int rho) { const int n = rho >> 4, i = rho & 15; return 8 * (i >> 2) + 4 * n + (i & 3); }

struct Unit { int pm, pn, k0, nt, part; };
struct Gemm { const bf16_t* A; const bf16_t* Bt; int M, N, K; };

struct StaticOrder {
    int nM, nN, nwg, G, c;
    __host__ __device__ void init(int M, int N, int G_, int c_) { nM = M / BM; nN = N / BM; nwg = nM * nN; G = G_; c = c_; }
    __host__ __device__ bool next(int i, Unit& u) const {
        const long L = (long)i * G + c; if (L >= nwg) return false;
        int wgid = (int)L; { const int q = nwg / NXCD, r = nwg % NXCD, xcd = wgid % NXCD, off = wgid / NXCD; wgid = (xcd < r ? xcd * (q + 1) : r * (q + 1) + (xcd - r) * q) + off; }
        const int nig = WGM * nN, gid = wgid / nig, fm = gid * WGM, gsz = (nM - fm) < WGM ? (nM - fm) : WGM;
        u.pm = fm + ((wgid % nig) % gsz); u.pn = (wgid % nig) / gsz; u.k0 = 0; u.nt = 0; u.part = 0; return true;
    }
    __device__ __forceinline__ void a_ready(const Unit&) const {}
    __device__ __forceinline__ void done(const Unit&) const {}
};

__device__ __forceinline__ unsigned cvt_pk_bf16(float lo, float hi) { unsigned r; asm volatile("v_cvt_pk_bf16_f32 %0, %1, %2" : "=v"(r) : "v"(lo), "v"(hi)); return r; }

template <class Epi, class Sched, bool ALIGN_EPI = false, bool SP2 = false>
__device__ __forceinline__ void gemm_phase(PG8_LAS unsigned char* lds, const Gemm g, const Sched& S, const Epi& E) {
    int tid_l = threadIdx.x; asm volatile("" : "+v"(tid_l)); const int tid = tid_l, wid = __builtin_amdgcn_readfirstlane(tid >> 6), lane = tid & 63, wr = wid >> 2, wc = wid & 3, fr = lane & 15, fq = lane >> 4;
    const int K = g.K;
    unsigned voffA[2], voffB[2];
#pragma unroll
    for (int i = 0; i < 2; ++i) { int R, C; stage_rc(tid * 16 + i * 8192, R, C); const int Rb = Epi::PERM ? ((R & ~31) + perm32(R & 31)) : R;
        voffA[i] = (unsigned)(R * K + C) * 2u; voffB[i] = (unsigned)(Rb * K + C) * 2u; }
    const size_t kstep = (size_t)(BK * 2);
    const size_t hstep = (size_t)HALF * K * 2;
    const size_t tstep = 2 * hstep;
    const unsigned ldsw = (unsigned)wid * 1024u;
    const int aoff = lds_byte(wr * 64 + fr, fq * 8), boff = lds_byte(wc * 32 + fr, fq * 8);
#define PG8_SA(b, h) (((b) * 2 + (h)) * HTB)
#define PG8_SB(b, h) ((4 + (b) * 2 + (h)) * HTB)
#define PG8_STAGE(bufoff, gbase, voff) do { _Pragma("unroll") for (int _i = 0; _i < 2; ++_i) \
        __builtin_amdgcn_global_load_lds((const unsigned*)((const char*)(gbase) + (voff)[_i]), (PG8_LAS unsigned*)(lds + (bufoff) + ldsw + _i * 8192), 16, 0, 0); } while (0)
#define PG8_LDA(dst, b, h) do { _Pragma("unroll") for (int m = 0; m < 4; ++m) _Pragma("unroll") for (int k = 0; k < 2; ++k) dst[m][k] = *(const PG8_LAS bf16x8*)(lds + PG8_SA(b, h) + aoff + m * 2048 + k * 1024); } while (0)
#define PG8_LDB(dst, b, h) do { _Pragma("unroll") for (int n = 0; n < 2; ++n) _Pragma("unroll") for (int k = 0; k < 2; ++k) dst[n][k] = *(const PG8_LAS bf16x8*)(lds + PG8_SB(b, h) + boff + n * 2048 + k * 1024); } while (0)
#define PG8_MMA(ai, bj, At, Bt) do { __builtin_amdgcn_s_setprio(1); _Pragma("unroll") for (int m = 0; m < 4; ++m) _Pragma("unroll") for (int n = 0; n < 2; ++n) _Pragma("unroll") for (int k = 0; k < 2; ++k) \
        acc[ai][bj][m][n] = __builtin_amdgcn_mfma_f32_16x16x32_bf16(Bt[n][k], At[m][k], acc[ai][bj][m][n], 0, 0, 0); __builtin_amdgcn_s_setprio(0); } while (0)
#define PG8_WAIT_V(n) asm volatile("s_waitcnt vmcnt(" #n ")" ::: "memory")
#define PG8_WAIT_L(n) asm volatile("s_waitcnt lgkmcnt(" #n ")" ::: "memory")
#define PG8_BAR __builtin_amdgcn_s_barrier()
#define PG8_SCHED __builtin_amdgcn_sched_barrier(0)
    Unit cur, nxt; int ui = 0;
    if (!S.next(0, cur)) return;
    f32x4 acc[2][2][4][2];
#pragma unroll
    for (int a = 0; a < 2; ++a)
#pragma unroll
        for (int b = 0; b < 2; ++b)
#pragma unroll
            for (int m = 0; m < 4; ++m)
#pragma unroll
                for (int n = 0; n < 2; ++n) acc[a][b][m][n] = (f32x4){0.f, 0.f, 0.f, 0.f};
    bf16x8 At[4][2], B0[2][2], B1[2][2];
    const char* cA = (const char*)g.A + (size_t)cur.pm * tstep + (size_t)cur.k0 * 2; const char* cB = (const char*)g.Bt + (size_t)cur.pn * tstep + (size_t)cur.k0 * 2;
    S.a_ready(cur);
    if constexpr (SP2) {
        PG8_STAGE(PG8_SB(0, 0), cB, voffB); PG8_STAGE(PG8_SB(0, 1), cB + hstep, voffB); PG8_STAGE(PG8_SA(0, 0), cA, voffA); PG8_STAGE(PG8_SA(0, 1), cA + hstep, voffA);
        if (wr == 1) PG8_BAR;
        PG8_WAIT_V(2); PG8_BAR;
        PG8_STAGE(PG8_SB(1, 0), cB + kstep, voffB); PG8_STAGE(PG8_SA(1, 0), cA + kstep, voffA); PG8_STAGE(PG8_SB(1, 1), cB + hstep + kstep, voffB);
        PG8_WAIT_V(6); PG8_BAR;
    } else {
        PG8_STAGE(PG8_SB(0, 0), cB, voffB); PG8_STAGE(PG8_SA(0, 0), cA, voffA); PG8_STAGE(PG8_SB(0, 1), cB + hstep, voffB); PG8_STAGE(PG8_SA(0, 1), cA + hstep, voffA);
        if (wr == 1) PG8_BAR;
        PG8_WAIT_V(4); PG8_BAR;
        PG8_STAGE(PG8_SB(1, 0), cB + kstep, voffB); PG8_STAGE(PG8_SA(1, 0), cA + kstep, voffA); PG8_STAGE(PG8_SB(1, 1), cB + hstep + kstep, voffB);
        PG8_WAIT_V(6); PG8_BAR;
    }
    for (;;) {
        const bool has_next = S.next(ui + 1, nxt);
        const char* nA = has_next ? (const char*)g.A + (size_t)nxt.pm * tstep + (size_t)nxt.k0 * 2 : cA; const char* nB = has_next ? (const char*)g.Bt + (size_t)nxt.pn * tstep + (size_t)nxt.k0 * 2 : cB;
        const int nt = cur.nt ? cur.nt : K / BK;
        for (int t = 0; t < nt; t += 2) {
            const bool last = (t == nt - 2);
            const char* a1 = cA + (size_t)(t + 1) * kstep;
            const char* a2 = last ? nA : cA + (size_t)(t + 2) * kstep; const char* b2 = last ? nB : cB + (size_t)(t + 2) * kstep;
            const char* a3 = a2 + kstep; const char* b3 = b2 + kstep;
            if (last && has_next) S.a_ready(nxt);
            if constexpr (SP2) {
            PG8_LDB(B0, 0, 0); PG8_LDB(B1, 0, 1); PG8_SCHED; PG8_LDA(At, 0, 0); PG8_STAGE(PG8_SA(1, 1), a1 + hstep, voffA);
            PG8_WAIT_V(8); PG8_WAIT_L(0); PG8_BAR; PG8_MMA(0, 0, At, B0); PG8_MMA(0, 1, At, B1); PG8_BAR; PG8_SCHED;
            PG8_LDA(At, 0, 1); PG8_STAGE(PG8_SB(0, 0), b2, voffB); PG8_STAGE(PG8_SB(0, 1), b2 + hstep, voffB); PG8_STAGE(PG8_SA(0, 0), a2, voffA);
            PG8_WAIT_V(8); PG8_WAIT_L(0); PG8_BAR; PG8_MMA(1, 0, At, B0); PG8_MMA(1, 1, At, B1); PG8_BAR; PG8_SCHED;
            PG8_LDB(B0, 1, 0); PG8_LDB(B1, 1, 1); PG8_SCHED; PG8_LDA(At, 1, 0); PG8_STAGE(PG8_SA(0, 1), a2 + hstep, voffA);
            PG8_WAIT_V(8); PG8_WAIT_L(0); PG8_BAR; PG8_MMA(0, 0, At, B0); PG8_MMA(0, 1, At, B1); PG8_BAR; PG8_SCHED;
            PG8_LDA(At, 1, 1); PG8_STAGE(PG8_SB(1, 0), b3, voffB); PG8_STAGE(PG8_SB(1, 1), b3 + hstep, voffB); PG8_STAGE(PG8_SA(1, 0), a3, voffA);
            PG8_WAIT_V(8); PG8_WAIT_L(0); PG8_BAR; PG8_MMA(1, 0, At, B0); PG8_MMA(1, 1, At, B1); PG8_BAR; PG8_SCHED;
            } else {
            PG8_LDB(B0, 0, 0); PG8_SCHED; PG8_LDA(At, 0, 0); PG8_STAGE(PG8_SA(1, 1), a1 + hstep, voffA);
            PG8_WAIT_L(8); PG8_BAR; PG8_WAIT_L(0); PG8_MMA(0, 0, At, B0); PG8_BAR; PG8_SCHED;
            PG8_LDB(B1, 0, 1); PG8_STAGE(PG8_SB(0, 0), b2, voffB);
            PG8_BAR; PG8_WAIT_L(0); PG8_MMA(0, 1, At, B1); PG8_BAR;
            PG8_LDA(At, 0, 1); PG8_STAGE(PG8_SA(0, 0), a2, voffA);
            PG8_BAR; PG8_WAIT_L(0); PG8_MMA(1, 0, At, B0); PG8_BAR; PG8_SCHED;
            PG8_STAGE(PG8_SB(0, 1), b2 + hstep, voffB);
            PG8_WAIT_V(6); PG8_BAR; PG8_MMA(1, 1, At, B1); PG8_BAR;
            PG8_LDB(B0, 1, 0); PG8_SCHED; PG8_LDA(At, 1, 0); PG8_STAGE(PG8_SA(0, 1), a2 + hstep, voffA);
            PG8_WAIT_L(8); PG8_BAR; PG8_WAIT_L(0); PG8_MMA(0, 0, At, B0); PG8_BAR; PG8_SCHED;
            PG8_LDB(B1, 1, 1); PG8_STAGE(PG8_SB(1, 0), b3, voffB);
            PG8_BAR; PG8_WAIT_L(0); PG8_MMA(0, 1, At, B1); PG8_BAR;
            PG8_LDA(At, 1, 1); PG8_STAGE(PG8_SA(1, 0), a3, voffA);
            PG8_BAR; PG8_WAIT_L(0); PG8_MMA(1, 0, At, B0); PG8_BAR; PG8_SCHED;
            PG8_STAGE(PG8_SB(1, 1), b3 + hstep, voffB);
            PG8_WAIT_V(6); PG8_BAR; PG8_MMA(1, 1, At, B1); PG8_BAR;
            }
        }
        if constexpr (ALIGN_EPI) { if (wr == 0) PG8_BAR; }
        if constexpr (!Epi::AFTER_DRAIN) { E(acc, cur, wr, wc, fr, fq); S.done(cur); }
        if (!has_next) break;
#pragma unroll
        for (int a = 0; a < 2; ++a)
#pragma unroll
            for (int b = 0; b < 2; ++b)
#pragma unroll
                for (int m = 0; m < 4; ++m)
#pragma unroll
                    for (int n = 0; n < 2; ++n) acc[a][b][m][n] = (f32x4){0.f, 0.f, 0.f, 0.f};
        cur = nxt; cA = nA; cB = nB; ++ui;
        if constexpr (ALIGN_EPI) { if (wr == 1) PG8_BAR; }
    }
    PG8_WAIT_V(0);
    if constexpr (!ALIGN_EPI) { if (wr == 0) PG8_BAR; }
    PG8_BAR;
    if constexpr (Epi::AFTER_DRAIN) { E.fused(acc, cur, wr, wc, fr, fq, lds, wid, lane); S.done(cur); }
#undef PG8_SA
#undef PG8_SB
#undef PG8_STAGE
#undef PG8_LDA
#undef PG8_LDB
#undef PG8_MMA
#undef PG8_WAIT_V
#undef PG8_WAIT_L
#undef PG8_BAR
#undef PG8_SCHED
}
}
#define XB_TMO      128
#define XB_XCNT(j)  (256  + 64 * (j))
#define XB_XSUB(j)  (1280 + 64 * (j))
#define XB_XGEN(j)  (2304 + 64 * (j))
#define XB_TOP      3328
#define XB_TOPGEN   3392
#define XCD_BAR_WORDS 3456
#define XB_SPIN_CAP (1u << 18)

__device__ __forceinline__ unsigned xb_ld(unsigned* p)              { return __hip_atomic_load(p, __ATOMIC_RELAXED, __HIP_MEMORY_SCOPE_AGENT); }
__device__ __forceinline__ unsigned xb_add(unsigned* p, unsigned v) { return __hip_atomic_fetch_add(p, v, __ATOMIC_RELAXED, __HIP_MEMORY_SCOPE_AGENT); }
__device__ __forceinline__ unsigned xb_xcc_id() { return (unsigned)__builtin_amdgcn_s_getreg((3 << 11) | 20) & 0xFu; }
#define XB_SPIN(cond, bar) do { unsigned _sp = 0; while (cond) { __builtin_amdgcn_s_sleep(1); \
    if ((++_sp & 255u) == 0u) { if (xb_ld(&(bar)[XB_TMO])) break; if (_sp > XB_SPIN_CAP) { atomicAdd(&(bar)[XB_TMO], 1u); break; } } } } while (0)

struct XcdBarrier {
    unsigned* bar; unsigned x;
    volatile LAS unsigned* st;
};

__device__ __forceinline__ XcdBarrier xcd_barrier_post(unsigned* bar, volatile LAS unsigned* st) {
    XcdBarrier b; b.bar = bar; b.x = xb_xcc_id(); b.st = st;
    if (threadIdx.x == 0) (void)xb_add(&bar[XB_XCNT(b.x)], 1u);
    return b;
}
__device__ __forceinline__ void xcd_barrier_complete(unsigned* bar, unsigned x, unsigned& nloc, unsigned& nx) {
    const unsigned G = gridDim.x * gridDim.y * gridDim.z;
    unsigned sum, cnt, mine, sp = 0u;
    for (;;) {
        sum = 0u; cnt = 0u; mine = 0u;
#pragma unroll
        for (unsigned j = 0; j < 16; ++j) { const unsigned c = xb_ld(&bar[XB_XCNT(j)]); sum += c; cnt += (c > 0u) ? 1u : 0u; mine = (j == x) ? c : mine; }
        if (sum == G) break;
        __builtin_amdgcn_s_sleep(1);
        if ((++sp & 255u) == 0u) { if (xb_ld(&bar[XB_TMO])) break; if (sp > XB_SPIN_CAP) { atomicAdd(&bar[XB_TMO], 1u); break; } }
    }
    nloc = mine > 0u ? mine : 1u; nx = cnt > 0u ? cnt : 1u;
}

__device__ __forceinline__ void xcd_barrier(const XcdBarrier& b) {
    asm volatile("s_waitcnt vmcnt(0)" ::: "memory");
    __syncthreads();
    if (threadIdx.x == 0) {
        unsigned* bar = b.bar;
        __builtin_amdgcn_s_waitcnt(0);
        unsigned nloc = b.st[0], nx = b.st[1];
        if (nloc == 0u) { xcd_barrier_complete(bar, b.x, nloc, nx); b.st[0] = nloc; b.st[1] = nx; }
        const unsigned old = xb_add(&bar[XB_XSUB(b.x)], 1u);
        const unsigned gen = old / nloc;
        if (old + 1u == (gen + 1u) * nloc) {
            __builtin_amdgcn_fence(__ATOMIC_RELEASE, "agent");
            asm volatile("s_waitcnt vmcnt(0)" ::: "memory");
            const unsigned og = xb_add(&bar[XB_TOP], 1u);
            const unsigned tg = og / nx;
            if (og + 1u == (tg + 1u) * nx) xb_add(&bar[XB_TOPGEN], 1u);
            else XB_SPIN(xb_ld(&bar[XB_TOPGEN]) == tg, bar);
            __builtin_amdgcn_fence(__ATOMIC_ACQUIRE, "agent");
            xb_add(&bar[XB_XGEN(b.x)], 1u);
            asm volatile("s_waitcnt vmcnt(0)" ::: "memory");
        } else {
            XB_SPIN(xb_ld(&bar[XB_XGEN(b.x)]) == gen, bar);
            __builtin_amdgcn_fence(__ATOMIC_ACQUIRE, "agent");
            asm volatile("s_waitcnt vmcnt(0)" ::: "memory");
        }
    }
    __syncthreads();
}


typedef __bf16 bf16x2_t __attribute__((ext_vector_type(2)));
__device__ __forceinline__ unsigned cvtpk(float lo, float hi) { f32x2 v = {lo, hi}; bf16x2_t b = __builtin_convertvector(v, bf16x2_t); return __builtin_bit_cast(unsigned, b); }
__device__ __forceinline__ float wave_sum(float v) {
#pragma unroll
    for (int o = 1; o < 64; o <<= 1) v += __shfl_xor(v, o);
    return v;
}
__device__ __forceinline__ float silu_f(float x) { return x / (1.f + __expf(-x)); }
__device__ __forceinline__ float logsigmoid_f(float z) { return fminf(z, 0.f) - __logf(1.f + __expf(-fabsf(z))); }
__device__ __forceinline__ int cond_of_row(int r) { return r < T_P ? 0 : 1 + ((r - T_P) >> 10); }
__device__ __forceinline__ int clampi(int v, int lo, int hi) { return v < lo ? lo : (v > hi ? hi : v); }

#ifndef ADA_DEFER
#define ADA_DEFER 1
#endif
#ifndef EPI_NT
#define EPI_NT 0
#endif
__device__ __forceinline__ void st16(void* p, u32x4 w) {
    if (EPI_NT == 2) asm volatile("global_store_dwordx4 %0, %1, off sc1\n\ts_nop 2" :: "v"(p), "v"(w) : "memory");
    else if (EPI_NT == 1) __builtin_nontemporal_store(w, (u32x4*)p); else *(u32x4*)p = w; }
struct Args { const float* in[21]; float* out; unsigned char* ws; int ph_lo, ph_hi; };
enum { IN_XP = 0, IN_XS, IN_CK, IN_CV, IN_SG, IN_C, IN_CCTX, IN_WADA, IN_BADA, IN_NORMG, IN_WQKV, IN_WONA, IN_RPB, IN_WQKVG, IN_WA1, IN_WA2, IN_BA, IN_GHEAD, IN_WOGLA, IN_W1, IN_W2 };
constexpr int PH_PRO = 0, PH_R0 = 1, PH_L0 = 2, PH_PER_LAYER = 8, NPH = PH_L0 + NL * PH_PER_LAYER;
enum { LP_MIX = 0, LP_CORE, LP_GATE, LP_WO, LP_ROWMID, LP_W1, LP_W2, LP_ROWEND };

struct E8NaQK {
    bf16* QK; float* newk; int li;
    __device__ __forceinline__ void store8(int row, int col, const float (&v)[8]) const {
        u32x4 w; w.x = cvtpk(v[0], v[1]); w.y = cvtpk(v[2], v[3]); w.z = cvtpk(v[4], v[5]); w.w = cvtpk(v[6], v[7]);
        { const int kpart = col >= 2048, c = col - 2048 * kpart, h = c >> 7, d = c & 127;
          st16(QK + (size_t)kpart * T * 2048 + ((size_t)h * T + row) * 128 + d, w); }
        if (col >= 2048 && row < T_P) {
            const int b = row >> 8, s = row & 255, c = col - 2048, h = c >> 7, d = c & 127;
            float* p = newk + ((((size_t)b * 2 + li) * 16 + h) * 256 + s) * 128 + d;
            *(f32x4*)p = (f32x4){v[0], v[1], v[2], v[3]}; *(f32x4*)(p + 4) = (f32x4){v[4], v[5], v[6], v[7]};
        }
    }
};
struct E8VT {
    bf16* VT; float* newv; int li;
    __device__ __forceinline__ void store8(int row, int col, const float (&v)[8]) const {
        u32x4 w; w.x = cvtpk(v[0], v[1]); w.y = cvtpk(v[2], v[3]); w.z = cvtpk(v[4], v[5]); w.w = cvtpk(v[6], v[7]);
        st16(VT + (size_t)row * VTP + col, w);
        if (newv && col < T_P) {
            const int b = col >> 8, s = col & 255, h = row >> 7, d = row & 127;
            float* p = newv + ((((size_t)b * 2 + li) * 16 + h) * 256 + s) * 128 + d;
#pragma unroll
            for (int e = 0; e < 8; ++e) p[(size_t)e * 128] = v[e];
        }
    }
};
struct E8GlaQKG {
    bf16* QK; float* TLR;
    __device__ __forceinline__ void store8(int row, int col, const float (&v)[8]) const {
        if (col < 4096) {
            u32x4 w; w.x = cvtpk(v[0], v[1]); w.y = cvtpk(v[2], v[3]); w.z = cvtpk(v[4], v[5]); w.w = cvtpk(v[6], v[7]);
            st16(QK + (size_t)row * 4096 + col, w);
        } else if (col < 4128) {
            float* p = TLR + (size_t)row * 32 + (col - 4096);
            *(f32x4*)p = (f32x4){v[0], v[1], v[2], v[3]}; *(f32x4*)(p + 4) = (f32x4){v[4], v[5], v[6], v[7]};
        }
    }
};
struct E8F32 {
    float* Y; int ldc;
    __device__ __forceinline__ void store8(int row, int col, const float (&v)[8]) const {
        float* p = Y + (size_t)row * ldc + col;
        *(f32x4*)p = (f32x4){v[0], v[1], v[2], v[3]}; *(f32x4*)(p + 4) = (f32x4){v[4], v[5], v[6], v[7]};
    }
};
struct E8Bf16 {
    bf16* O; int ldc;
    __device__ __forceinline__ void store8(int row, int col, const float (&v)[8]) const {
        u32x4 w; w.x = cvtpk(v[0], v[1]); w.y = cvtpk(v[2], v[3]); w.z = cvtpk(v[4], v[5]); w.w = cvtpk(v[6], v[7]);
        st16(O + (size_t)row * ldc + col, w);
    }
};
struct E8Relu2 {
    bf16* O; int ldc;
    __device__ __forceinline__ void store8(int row, int col, const float (&v)[8]) const {
        float r[8];
#pragma unroll
        for (int e = 0; e < 8; ++e) { const float t = fmaxf(v[e], 0.f); r[e] = t * t; }
        u32x4 w; w.x = cvtpk(r[0], r[1]); w.y = cvtpk(r[2], r[3]); w.z = cvtpk(r[4], r[5]); w.w = cvtpk(r[6], r[7]);
        st16(O + (size_t)row * ldc + col, w);
    }
};
template <class E8> struct EpiWrap {
    static constexpr bool PERM = true, AFTER_DRAIN = false;
    E8 e;
    __device__ __forceinline__ void operator()(const pg8::f32x4 (&acc)[2][2][4][2], const pg8::Unit& u, int wr, int wc, int fr, int fq) const {
        const int row0 = u.pm * 256 + wr * 64 + fr, col0 = u.pn * 256 + wc * 32 + 8 * fq;
#pragma unroll
        for (int ai = 0; ai < 2; ++ai)
#pragma unroll
            for (int m = 0; m < 4; ++m)
#pragma unroll
                for (int bj = 0; bj < 2; ++bj) {
                    const pg8::f32x4 a = acc[ai][bj][m][0], b = acc[ai][bj][m][1];
                    const float v[8] = {a[0], a[1], a[2], a[3], b[0], b[1], b[2], b[3]};
                    e.store8(row0 + ai * 128 + m * 16, col0 + bj * 128, v);
                }
    }
};

constexpr int W2_NT_MAIN = 100;
struct SplitKOrder {
    int c;
    __device__ static void map(int L, pg8::Unit& u) {
        const int nM = 24, nN = 8, nwg = 192;
        int wgid = L; { const int q = nwg / 8, xcd = wgid % 8, off = wgid / 8; wgid = xcd * q + off; }
        const int nig = 8 * nN, gid = wgid / nig, fm = gid * 8, gsz = (nM - fm) < 8 ? (nM - fm) : 8;
        u.pm = fm + ((wgid % nig) % gsz); u.pn = (wgid % nig) / gsz;
    }
    __device__ bool next(int i, pg8::Unit& u) const {
        if (c < 192) { if (i > 0) return false; map(c, u); u.k0 = 0; u.nt = W2_NT_MAIN; u.part = 0; return true; }
        if (i >= 3) return false;
        map(3 * (c - 192) + i, u); u.k0 = W2_NT_MAIN * 64; u.nt = 128 - W2_NT_MAIN; u.part = 1; return true;
    }
    __device__ __forceinline__ void a_ready(const pg8::Unit&) const {}
    __device__ __forceinline__ void done(const pg8::Unit&) const {}
};
struct EpiF32Part {
    static constexpr bool PERM = true, AFTER_DRAIN = false;
    float* Y0; float* Y1;
    __device__ __forceinline__ void operator()(const pg8::f32x4 (&acc)[2][2][4][2], const pg8::Unit& u, int wr, int wc, int fr, int fq) const {
        const int row0 = u.pm * 256 + wr * 64 + fr, col0 = u.pn * 256 + wc * 32 + 8 * fq;
        float* Y = u.part ? Y1 : Y0;
#pragma unroll
        for (int ai = 0; ai < 2; ++ai)
#pragma unroll
            for (int m = 0; m < 4; ++m)
#pragma unroll
                for (int bj = 0; bj < 2; ++bj) {
                    float* p = Y + (size_t)(row0 + ai * 128 + m * 16) * D + col0 + bj * 128;
                    *(f32x4*)p = acc[ai][bj][m][0]; *(f32x4*)(p + 4) = acc[ai][bj][m][1];
                }
    }
};

__device__ __forceinline__ void tr_item(const float* src, size_t ldsrc, bf16* dst, size_t lddst, LAS float* scr, int lane) {
    const float* sp_ = src + (size_t)(lane >> 5) * ldsrc + (lane & 31); LAS float* dp_ = scr + (lane >> 5) * 33 + (lane & 31);
#pragma unroll 1
    for (int h = 0; h < 2; ++h, sp_ += 32 * ldsrc, dp_ += 32 * 33) {
        float tv[16];
#pragma unroll
        for (int i = 0; i < 16; ++i) tv[i] = __builtin_nontemporal_load(sp_ + (size_t)(2 * i) * ldsrc);
#pragma unroll
        for (int i = 0; i < 16; ++i) dp_[2 * i * 33] = tv[i];
    }
    LDS_WAIT(); asm volatile("" ::: "memory");
    const int c = lane & 7;
#pragma unroll
    for (int j = 0; j < 4; ++j) { const int n = (lane >> 3) + 8 * j; const LAS float* s = scr + (8 * c) * 33 + n;
        u32x4 o; o.x = cvtpk(s[0 * 33], s[1 * 33]); o.y = cvtpk(s[2 * 33], s[3 * 33]); o.z = cvtpk(s[4 * 33], s[5 * 33]); o.w = cvtpk(s[6 * 33], s[7 * 33]);
        *(u32x4*)(dst + (size_t)n * lddst + 8 * c) = o; }
    LDS_WAIT(); asm volatile("" ::: "memory");
}
constexpr int PRO_SCR_BYTES = 8448, PRO_SILU_OFF = 8 * PRO_SCR_BYTES  , PRO_PART_OFF = PRO_SILU_OFF + 3 * 2048 * 4  ;
constexpr int LY_ADA = 192, LY_TR = 3072, LY_A1 = 32, LY_ITEMS = LY_ADA + LY_TR + LY_A1;

__device__ __forceinline__ void silu_table(const Args& a, LAS unsigned char* lds, int tid) {
    LAS float* sil = (LAS float*)(lds + PRO_SILU_OFF);
    for (int e = tid; e < 3 * 2048; e += 512) { const int c = e >> 11, k = e & 2047; const float x = c == 0 ? a.in[IN_CCTX][k] : a.in[IN_C][(c - 1) * 2048 + k]; sil[e] = silu_f(x); }
    __syncthreads();
}
__device__ __forceinline__ void ada_layer(const Args& a, LAS unsigned char* lds, int l, int b0, int nb, int tid) {
    const int lane = tid & 63, wave = __builtin_amdgcn_readfirstlane(tid >> 6);
    LAS float* sil = (LAS float*)(lds + PRO_SILU_OFF);
    LAS float* part = (LAS float*)(lds + PRO_PART_OFF);
    for (int cg = b0; cg < LY_ADA; cg += nb) {
        const float* W = a.in[IN_WADA] + (size_t)l * 2048 * 12288 + cg * 64 + lane;
        float a0 = 0.f, a1 = 0.f, a2 = 0.f;
        const int k0 = wave * 256;
#pragma unroll 1
        for (int kc = 0; kc < 256; kc += 16) {
            float wv[16];
#pragma unroll
            for (int k = 0; k < 16; ++k) wv[k] = __builtin_nontemporal_load(W + (size_t)(k0 + kc + k) * 12288);
#pragma unroll
            for (int k = 0; k < 16; ++k) { a0 += sil[k0 + kc + k] * wv[k]; a1 += sil[2048 + k0 + kc + k] * wv[k]; a2 += sil[4096 + k0 + kc + k] * wv[k]; }
        }
        part[(wave * 3 + 0) * 64 + lane] = a0; part[(wave * 3 + 1) * 64 + lane] = a1; part[(wave * 3 + 2) * 64 + lane] = a2;
        __syncthreads();
        if (tid < 192) { const int c = tid >> 6, col = tid & 63; float sacc = 0.f;
#pragma unroll
            for (int w = 0; w < 8; ++w) sacc += part[(w * 3 + c) * 64 + col];
            ((float*)(a.ws + WS_MOD))[((size_t)l * 3 + c) * 12288 + cg * 64 + col] = sacc + a.in[IN_BADA][l * 12288 + cg * 64 + col]; }
        __syncthreads();
    }
}
__device__ __forceinline__ void convert_weights(const Args& a, LAS unsigned char* lds, int l, int it_lo, int it_hi, int b0, int nb, int tid) {
    const int lane = tid & 63, wave = __builtin_amdgcn_readfirstlane(tid >> 6);
    LAS float* scr = (LAS float*)(lds + wave * PRO_SCR_BYTES);
    unsigned char* ws = a.ws;
    const int i = l >> 1; const bool gla = l & 1;
    for (int it = it_lo + b0; it < it_hi; it += nb) {
        int r = it;
        if (r < LY_TR) {
            if (r < 768) {
                const int kb = r / 24, nb2 = r % 24;
                const float* src = (gla ? a.in[IN_WQKVG] : a.in[IN_WQKV]) + (size_t)i * 2048 * 6144;
                int db = nb2; if (gla) { if (nb2 >= 16) db = 8 + (nb2 - 16); else if (nb2 >= 8) db = 17 + (nb2 - 8); }
                bf16* dst = (bf16*)(ws + WS_WMIX) + (size_t)l * NMIX * D;
                tr_item(src + (size_t)(kb * 64) * 6144 + nb2 * 256 + wave * 32, 6144, dst + (size_t)(db * 256 + wave * 32) * D + kb * 64, D, scr, lane);
            } else if (r < 1024) {
                r -= 768; const int kb = r / 8, nb2 = r % 8;
                const float* src = (gla ? a.in[IN_WOGLA] : a.in[IN_WONA]) + (size_t)i * 2048 * 2048;
                bf16* dst = (bf16*)(ws + WS_WO) + (size_t)l * D * D;
                tr_item(src + (size_t)(kb * 64) * 2048 + nb2 * 256 + wave * 32, 2048, dst + (size_t)(nb2 * 256 + wave * 32) * D + kb * 64, D, scr, lane);
            } else if (r < 2048) {
                r -= 1024; const int kb = r / 32, nb2 = r % 32;
                const float* src = a.in[IN_W1] + (size_t)l * 2048 * 8192;
                bf16* dst = (bf16*)(ws + WS_W1) + (size_t)l * FF * D;
                tr_item(src + (size_t)(kb * 64) * 8192 + nb2 * 256 + wave * 32, 8192, dst + (size_t)(nb2 * 256 + wave * 32) * D + kb * 64, D, scr, lane);
            } else {
                r -= 2048; const int kb = r / 8, nb2 = r % 8;
                const float* src = a.in[IN_W2] + (size_t)l * 8192 * 2048;
                bf16* dst = (bf16*)(ws + WS_W2) + (size_t)l * D * FF;
                tr_item(src + (size_t)(kb * 64) * 2048 + nb2 * 256 + wave * 32, 2048, dst + (size_t)(nb2 * 256 + wave * 32) * FF + kb * 64, FF, scr, lane);
            }
            continue;
        }
        r -= LY_TR;
        if (gla) {
            const int p = r;
            bf16* dst = (bf16*)(ws + WS_WMIX) + (size_t)l * NMIX * D + (size_t)4096 * D;
            for (int q = 0; q < 32; ++q) { const int e = tid + 512 * q, rr = e >> 11, k = e & 2047, prow = 8 * p + rr;
                float val = 0.f; if (prow < 32) val = a.in[IN_WA1][(((size_t)i * 2 + (prow >> 4)) * 2048 + k) * 16 + (prow & 15)];
                dst[(size_t)prow * D + k] = (bf16)f2bf(val); }
        }
    }
}
constexpr int CV_WITEMS = LY_TR + LY_A1;
#ifndef CVMIX
#define CVMIX 1100
#define CVWO 1500
#define CVW2 3104
#endif
constexpr int CV_MIX_END = CVMIX, CV_WO_END = CVWO, CV_W2_END = CVW2;
constexpr int PRO_CK = 512, PRO_CV = 128;
__device__ __forceinline__ void prologue_phase(const Args& a, LAS unsigned char* lds, int bid, int G, int tid) {
    const int lane = tid & 63, wave = __builtin_amdgcn_readfirstlane(tid >> 6);
    LAS float* scr = (LAS float*)(lds + wave * PRO_SCR_BYTES);
    unsigned char* ws = a.ws;
    silu_table(a, lds, tid);
    const bool defer = (G == 256);
    for (int l = 0; l < ((ADA_DEFER && defer) ? 1 : NL); ++l) ada_layer(a, lds, l, (bid + 64 * l) % G, G, tid);
    convert_weights(a, lds, 0, 0, CV_WITEMS, bid, G, tid);
    for (int l = 1; l < NL; ++l) convert_weights(a, lds, l, defer ? CV_W2_END : 0, CV_WITEMS, (bid + 37 * l) % G, G, tid);
    for (int r = bid; r < PRO_CK + PRO_CV; r += G) {
        if (r < PRO_CK) {
            const size_t e0 = ((size_t)r * 512 + tid) * 8;
            const f32x4 x0 = *(const f32x4*)(a.in[IN_CK] + e0), x1 = *(const f32x4*)(a.in[IN_CK] + e0 + 4);
            u32x4 w; w.x = cvtpk(x0[0], x0[1]); w.y = cvtpk(x0[2], x0[3]); w.z = cvtpk(x1[0], x1[1]); w.w = cvtpk(x1[2], x1[3]);
            *(u32x4*)((bf16*)(ws + WS_CK) + e0) = w;
        } else {
            const int rr = r - PRO_CK, mat = rr >> 1, kh = rr & 1, kb = kh * 2 + (wave >> 2), nb2 = wave & 3;
            tr_item(a.in[IN_CV] + (size_t)mat * 256 * 128 + (size_t)(kb * 64) * 128 + nb2 * 32, 128, (bf16*)(ws + WS_CVT) + (size_t)mat * 128 * 256 + (size_t)(nb2 * 32) * 256 + kb * 64, 256, scr, lane);
        }
    }
}

template <bool FIRST, bool UPD, bool EMIT, bool ADD2 = false>
__device__ __forceinline__ void row_phase(const Args& a, int gw, int ngw, int lane, const float* ga, const float* modU, int jgate, const float* gb, const float* modE, int jshift, int jscale) {
    float* X = a.out + OUT_X; const float* Y = (const float*)(a.ws + WS_Y); bf16* H = (bf16*)(a.ws + WS_H);
    const int rpw = (T + ngw - 1) / ngw, r0 = gw * rpw, r1 = (r0 + rpw < T) ? r0 + rpw : T;
    f32x4 c1[8], c2[8], c3[8];
    int cur = -1;
    for (int r = r0; r < r1; ++r) {
        const int cond = cond_of_row(r);
        if (cond != cur) {
            cur = cond;
            if (UPD) { const float* gate = modU + ((size_t)cond * 6 + jgate) * D;
#pragma unroll
                for (int j = 0; j < 8; ++j) c1[j] = *(const f32x4*)(gate + 256 * j + 4 * lane) * *(const f32x4*)(ga + 256 * j + 4 * lane); }
            if (EMIT) { const float* sh = modE + ((size_t)cond * 6 + jshift) * D; const float* sc = modE + ((size_t)cond * 6 + jscale) * D;
#pragma unroll
                for (int j = 0; j < 8; ++j) { c2[j] = *(const f32x4*)(gb + 256 * j + 4 * lane) * (*(const f32x4*)(sc + 256 * j + 4 * lane) + 1.f); c3[j] = *(const f32x4*)(sh + 256 * j + 4 * lane); } }
        }
        const float* xin = FIRST ? (r < T_P ? a.in[IN_XP] + (size_t)r * D : a.in[IN_XS] + (size_t)(r - T_P) * D) : X + (size_t)r * D;
        f32x4 x[8];
#pragma unroll
        for (int j = 0; j < 8; ++j) x[j] = *(const f32x4*)(xin + 256 * j + 4 * lane);
        if (UPD) {
            f32x4 y[8]; float ss = 0.f;
#pragma unroll
            for (int j = 0; j < 8; ++j) {
                if (Y_BF16) { const u32x2 yw = *(const u32x2*)((const bf16*)Y + (size_t)r * D + 256 * j + 4 * lane); y[j] = (f32x4){bflo(yw.x), bfhi(yw.x), bflo(yw.y), bfhi(yw.y)}; }
                else { y[j] = *(const f32x4*)(Y + (size_t)r * D + 256 * j + 4 * lane); if (ADD2) y[j] = y[j] + *(const f32x4*)(Y + (size_t)T * D + (size_t)r * D + 256 * j + 4 * lane); }
                ss += (y[j][0] * y[j][0] + y[j][1] * y[j][1]) + (y[j][2] * y[j][2] + y[j][3] * y[j][3]); }
            const float rinv = rsqrtf(wave_sum(ss) * (1.f / D) + EPS);
#pragma unroll
            for (int j = 0; j < 8; ++j) x[j] = x[j] + c1[j] * (y[j] * rinv);
        }
        if (FIRST || UPD) {
#pragma unroll
            for (int j = 0; j < 8; ++j) *(f32x4*)(X + (size_t)r * D + 256 * j + 4 * lane) = x[j];
        }
        if (EMIT) {
            float ss = 0.f;
#pragma unroll
            for (int j = 0; j < 8; ++j) ss += (x[j][0] * x[j][0] + x[j][1] * x[j][1]) + (x[j][2] * x[j][2] + x[j][3] * x[j][3]);
            const float rinv = rsqrtf(wave_sum(ss) * (1.f / D) + EPS);
#pragma unroll
            for (int j = 0; j < 8; ++j) { const f32x4 h = (x[j] * rinv) * c2[j] + c3[j];
                u32x2 w; w.x = cvtpk(h[0], h[1]); w.y = cvtpk(h[2], h[3]);
                *(u32x2*)(H + (size_t)r * D + 256 * j + 4 * lane) = w; }
        }
    }
}

__device__ __forceinline__ void gla_gate_phase(const Args& a, int gw, int ngw, int lane, int li) {
    const float* OG = (const float*)(a.ws + WS_OG); const bf16* QK = (const bf16*)(a.ws + WS_QK); bf16* AO = (bf16*)(a.ws + WS_AO);
    const float* gh = a.in[IN_GHEAD] + (size_t)li * 512;
    for (int r = gw; r < T; r += ngw) {
        f32x4 o[8];
#pragma unroll
        for (int j = 0; j < 8; ++j) {
            if (OG_BF16) { const bf16* og = (const bf16*)OG; const u32x2 p0 = *(const u32x2*)(og + (size_t)r * D + 256 * j + 4 * lane), p1 = *(const u32x2*)(og + (size_t)T * D + (size_t)r * D + 256 * j + 4 * lane);
                o[j] = (f32x4){bflo(p0.x) + bflo(p1.x), bfhi(p0.x) + bfhi(p1.x), bflo(p0.y) + bflo(p1.y), bfhi(p0.y) + bfhi(p1.y)}; }
            else o[j] = *(const f32x4*)(OG + (size_t)r * D + 256 * j + 4 * lane) + *(const f32x4*)(OG + (size_t)T * D + (size_t)r * D + 256 * j + 4 * lane);
        }
#pragma unroll
        for (int hh = 0; hh < 4; ++hh) {
            float ss = 0.f;
#pragma unroll
            for (int jj = 0; jj < 2; ++jj) { const f32x4 v = o[2 * hh + jj]; ss += (v[0] * v[0] + v[1] * v[1]) + (v[2] * v[2] + v[3] * v[3]); }
            const float rinv = rsqrtf(wave_sum(ss) * (1.f / 512.f) + EPS);
#pragma unroll
            for (int jj = 0; jj < 2; ++jj) { const int j = 2 * hh + jj, c = 256 * j + 4 * lane;
                const f32x4 g = *(const f32x4*)(gh + (c & 511));
                const u32x2 gw2 = *(const u32x2*)(QK + (size_t)r * 4096 + 2048 + c);
                const float g0 = bflo(gw2.x), g1 = bfhi(gw2.x), g2 = bflo(gw2.y), g3 = bfhi(gw2.y);
                const f32x4 v = o[j] * rinv * g;
                u32x2 w; w.x = cvtpk(v[0] * silu_f(g0), v[1] * silu_f(g1)); w.y = cvtpk(v[2] * silu_f(g2), v[3] * silu_f(g3));
                *(u32x2*)(AO + (size_t)r * D + c) = w; }
        }
    }
}

template <class E8> __global__ __launch_bounds__(256) void ref_gemm(const bf16* A, const bf16* Bt, int M, int N, int K, E8 E) {
    __shared__ __attribute__((aligned(16))) float As[32][68]; __shared__ __attribute__((aligned(16))) float Bs[32][68];
    const int t = threadIdx.x, m0 = blockIdx.y * 64, n0 = blockIdx.x * 64, lr = t >> 2, lk = (t & 3) * 8, ty = t >> 3, tx = t & 7;
    float acc[2][8];
#pragma unroll
    for (int i = 0; i < 2; ++i)
#pragma unroll
        for (int j = 0; j < 8; ++j) acc[i][j] = 0.f;
    for (int k0 = 0; k0 < K; k0 += 32) {
        const u32x4 av = *(const u32x4*)(A + (size_t)(m0 + lr) * K + k0 + lk), bv = *(const u32x4*)(Bt + (size_t)(n0 + lr) * K + k0 + lk);
        __syncthreads();
        As[lk + 0][lr] = bflo(av.x); As[lk + 1][lr] = bfhi(av.x); As[lk + 2][lr] = bflo(av.y); As[lk + 3][lr] = bfhi(av.y); As[lk + 4][lr] = bflo(av.z); As[lk + 5][lr] = bfhi(av.z); As[lk + 6][lr] = bflo(av.w); As[lk + 7][lr] = bfhi(av.w);
        Bs[lk + 0][lr] = bflo(bv.x); Bs[lk + 1][lr] = bfhi(bv.x); Bs[lk + 2][lr] = bflo(bv.y); Bs[lk + 3][lr] = bfhi(bv.y); Bs[lk + 4][lr] = bflo(bv.z); Bs[lk + 5][lr] = bfhi(bv.z); Bs[lk + 6][lr] = bflo(bv.w); Bs[lk + 7][lr] = bfhi(bv.w);
        __syncthreads();
#pragma unroll 8
        for (int kk = 0; kk < 32; ++kk) {
            const float a0 = As[kk][2 * ty], a1 = As[kk][2 * ty + 1];
            const f32x4 b0 = *(const f32x4*)&Bs[kk][8 * tx], b1 = *(const f32x4*)&Bs[kk][8 * tx + 4];
#pragma unroll
            for (int j = 0; j < 4; ++j) { acc[0][j] += a0 * b0[j]; acc[0][4 + j] += a0 * b1[j]; acc[1][j] += a1 * b0[j]; acc[1][4 + j] += a1 * b1[j]; }
        }
    }
    E.store8(m0 + 2 * ty, n0 + 8 * tx, acc[0]); E.store8(m0 + 2 * ty + 1, n0 + 8 * tx, acc[1]);
}

__global__ __launch_bounds__(128) void ref_attn(Args a, int li) {
    __shared__ float qs[128]; __shared__ float sc[768]; __shared__ float red[4];
    const bf16* QK = (const bf16*)(a.ws + WS_QK); const bf16* VT = (const bf16*)(a.ws + WS_VT); const bf16* CK = (const bf16*)(a.ws + WS_CK); const bf16* CVT = (const bf16*)(a.ws + WS_CVT);
    bf16* AO = (bf16*)(a.ws + WS_AO);
    const int tok = blockIdx.x >> 4, h = blockIdx.x & 15, tid = threadIdx.x;
    qs[tid] = bf2f(QK[((size_t)h * T + tok) * 128 + tid]);
    __syncthreads();
    const bool lat = tok >= T_P; const int nkeys = lat ? 768 : 256;
    const int bs = lat ? (tok - T_P) >> 10 : 0, tt = (tok - T_P) & 1023, r = tt >> 6, cq = tt & 63, row_start = clampi(r - 4, 0, 8), col_start = clampi(cq - 8, 0, 48);
    const float scale = 0.08838834764831845f;
    float lmax = -3.0e38f;
    for (int key = tid; key < nkeys; key += 128) {
        const bf16* kp; bool valid = true; float bias = 0.f;
        if (!lat) kp = QK + (size_t)T * 2048 + ((size_t)h * T + (tok & ~255) + key) * 128;
        else if (key < 512) { const int kri = key >> 6, ck = key & 63, krow = row_start + kri;
            kp = QK + (size_t)T * 2048 + ((size_t)h * T + T_P + bs * 1024 + krow * 64 + ck) * 128;
            valid = ck >= col_start && ck < col_start + 16;
            const int dr = krow - r + 7, dc = clampi(ck - cq + 15, 0, 30);
            bias = a.in[IN_RPB][(((size_t)li * 16 + h) * 15 + dr) * 31 + dc];
        } else kp = CK + ((((size_t)bs * 2 + li) * 16 + h) * 256 + (key - 512)) * 128;
        float s = 0.f;
        for (int d = 0; d < 128; ++d) s += qs[d] * bf2f(kp[d]);
        s = valid ? s * scale + bias : -1e30f;
        sc[key] = s; lmax = fmaxf(lmax, s);
    }
    for (int o = 32; o >= 1; o >>= 1) lmax = fmaxf(lmax, __shfl_xor(lmax, o));
    if ((tid & 63) == 0) red[tid >> 6] = lmax;
    __syncthreads();
    const float mx = fmaxf(red[0], red[1]);
    float lsum = 0.f;
    for (int key = tid; key < nkeys; key += 128) { const float p = __expf(sc[key] - mx); sc[key] = p; lsum += p; }
    for (int o = 32; o >= 1; o >>= 1) lsum += __shfl_xor(lsum, o);
    if ((tid & 63) == 0) red[2 + (tid >> 6)] = lsum;
    __syncthreads();
    const float inv = 1.f / (red[2] + red[3]);
    float o = 0.f; const int d = tid;
    if (!lat) { const bf16* vp = VT + (size_t)(h * 128 + d) * VTP + (tok & ~255); for (int key = 0; key < 256; ++key) o += sc[key] * bf2f(vp[key]); }
    else {
        const bf16* vp = VT + (size_t)(h * 128 + d) * VTP + T_P + bs * 1024 + row_start * 64; for (int key = 0; key < 512; ++key) o += sc[key] * bf2f(vp[key]);
        const bf16* cp = CVT + ((((size_t)bs * 2 + li) * 16 + h) * 128 + d) * 256; for (int key = 0; key < 256; ++key) o += sc[512 + key] * bf2f(cp[key]);
    }
    AO[(size_t)tok * D + h * 128 + d] = (bf16)f2bf(o * inv);
}

__device__ __forceinline__ float rope_dim(const bf16* xp, int j, int pos_r, int pos_c) {
    const int half = j >> 7, second = (j >> 6) & 1, i = j & 63;
    const float x1 = bf2f(xp[half * 128 + i]), x2 = bf2f(xp[half * 128 + 64 + i]);
    const float freq = exp2f(-(float)i * (13.287712379549449f / 64.f));
    const float ang = (float)(half ? pos_c : pos_r) * freq;
    float rev = ang * 0.15915494309189535f; rev -= floorf(rev);
    const float sn = __builtin_amdgcn_sinf(rev), cs = __builtin_amdgcn_cosf(rev);
    return second ? (x1 * sn + x2 * cs) : (x1 * cs - x2 * sn);
}
__global__ __launch_bounds__(256) void ref_gla(Args a, int li) {
    __shared__ float red[4][8];
    const bf16* QK = (const bf16*)(a.ws + WS_QK); const bf16* VT = (const bf16*)(a.ws + WS_VT); const float* TLR = (const float*)(a.ws + WS_TLR); float* OG = (float*)(a.ws + WS_OG);
    int u = blockIdx.x; const int dvg = u & 63; u >>= 6; const int dir = u & 1; u >>= 1; const int hh = u & 3; const int seq = u >> 2;
    const int j = threadIdx.x, lane = j & 63, wv = j >> 6;
    const bool lat = seq >= 16; const int tb = lat ? T_P + (seq - 16) * 1024 : seq * 256, L = lat ? 1024 : 256, dv0 = dvg * 8;
    float S[8];
#pragma unroll
    for (int e = 0; e < 8; ++e) S[e] = lat ? a.in[IN_SG][(((((size_t)(seq - 16) * 2 + li) * 2 + dir) * 4 + hh) * 256 + j) * 512 + dv0 + e] : 0.f;
    float w2[16];
#pragma unroll
    for (int r = 0; r < 16; ++r) w2[r] = a.in[IN_WA2][(((size_t)li * 2 + dir) * 16 + r) * 1024 + hh * 256 + j];
    const float bz = a.in[IN_BA][((size_t)li * 2 + dir) * 1024 + hh * 256 + j];
    for (int p = 0; p < L; ++p) {
        const int to = dir ? L - 1 - p : p, tok = tb + to;
        float z = bz;
#pragma unroll
        for (int r = 0; r < 16; ++r) z += TLR[(size_t)tok * 32 + dir * 16 + r] * w2[r];
        const float dec = __expf(logsigmoid_f(z) * (1.f / 16.f));
        float qv, kv;
        const bf16* qp = QK + (size_t)tok * 4096 + hh * 256; const bf16* kp = qp + 1024;
        if (lat) { qv = rope_dim(qp, j, to >> 6, to & 63); kv = rope_dim(kp, j, to >> 6, to & 63); } else { qv = bf2f(qp[j]); kv = bf2f(kp[j]); }
        qv *= 0.0625f;
        float pr[8];
#pragma unroll
        for (int e = 0; e < 8; ++e) { const float v = bf2f(VT[(size_t)(hh * 512 + dv0 + e) * VTP + tok]); S[e] = dec * S[e] + kv * v; pr[e] = qv * S[e]; }
#pragma unroll
        for (int e = 0; e < 8; ++e) { float s = pr[e]; for (int o = 32; o >= 1; o >>= 1) s += __shfl_xor(s, o); pr[e] = s; }
        __syncthreads();
        if (lane == 0) {
#pragma unroll
            for (int e = 0; e < 8; ++e) red[wv][e] = pr[e]; }
        __syncthreads();
        if (j < 8) OG[(size_t)dir * T * D + (size_t)tok * D + hh * 512 + dv0 + j] = (red[0][j] + red[1][j]) + (red[2][j] + red[3][j]);
    }
    if (!lat) {
#pragma unroll
        for (int e = 0; e < 8; ++e) a.out[OUT_GLA + (((((size_t)seq * 2 + li) * 2 + dir) * 4 + hh) * 256 + j) * 512 + dv0 + e] = S[e];
    }
}

#define MFMA16(a, b, c) __builtin_amdgcn_mfma_f32_16x16x32_bf16((a), (b), (c), 0, 0, 0)
struct AttState { f32x4 o[8]; float m, l; };

struct AttFrags { bf16x8 kf[2][4]; bf16x8 vf[8]; };
constexpr int AT_KP = 136, AT_VP = 72, AT_KB = 64 * AT_KP * 2  , AT_VB = 128 * AT_VP * 2  , AT_STAGE = AT_KB + AT_VB  , AT_RP = 2 * AT_STAGE  ;
struct AttSrc { const bf16* kb; const bf16* vb; int vstride; };

__device__ __forceinline__ void attn_half(AttState& st, const bf16x8 (&qf)[4], LAS unsigned char* lds, unsigned kfo, unsigned vfo, int kg, int lat, int rprow, int ck0, int qcol, int col_start) {
    const float SC = 0.08838834764831845f * LOG2E;
    AttFrags f;
#pragma unroll
    for (int s = 0; s < 2; ++s)
#pragma unroll
        for (int c = 0; c < 4; ++c) f.kf[s][c] = *(const LAS bf16x8*)(lds + kfo + s * (4 * AT_KP * 2) + c * 64);
#pragma unroll
    for (int dt = 0; dt < 8; ++dt) f.vf[dt] = *(const LAS bf16x8*)(lds + vfo + dt * (16 * AT_VP * 2));
    f32x4 sa[2];
#pragma unroll
    for (int s = 0; s < 2; ++s) { f32x4 acc = {0.f, 0.f, 0.f, 0.f};
#pragma unroll
        for (int c = 0; c < 4; ++c) acc = MFMA16(f.kf[s][c], qf[c], acc);
        sa[s] = acc; }
    const LAS float* rp = (const LAS float*)(lds + AT_RP);
    float mx = -1e30f; float v[8];
#pragma unroll
    for (int e = 0; e < 8; ++e) { const int ck = ck0 + 8 * kg + e; const bool valid = !lat || (ck >= col_start && ck < col_start + 16);
        const float b = lat ? rp[rprow * 32 + clampi(ck - qcol + 15, 0, 30)] * LOG2E : 0.f;
        v[e] = valid ? sa[e >> 2][e & 3] * SC + b : -1e30f; mx = fmaxf(mx, v[e]); }
    mx = fmaxf(mx, __shfl_xor(mx, 16)); mx = fmaxf(mx, __shfl_xor(mx, 32));
    const float mn = fmaxf(st.m, mx), alpha = __builtin_amdgcn_exp2f(st.m - mn);
    float ps = 0.f; float p[8];
#pragma unroll
    for (int e = 0; e < 8; ++e) { const float ex = __builtin_amdgcn_exp2f(v[e] - mn); p[e] = v[e] > -1e29f ? ex : 0.f; ps += p[e]; }
    u32x4 w; w.x = cvtpk(p[0], p[1]); w.y = cvtpk(p[2], p[3]); w.z = cvtpk(p[4], p[5]); w.w = cvtpk(p[6], p[7]);
    const bf16x8 pf = __builtin_bit_cast(bf16x8, w);
    ps += __shfl_xor(ps, 16); ps += __shfl_xor(ps, 32);
    st.l = st.l * alpha + ps; st.m = mn;
#pragma unroll
    for (int dt = 0; dt < 8; ++dt) st.o[dt] = MFMA16(f.vf[dt], pf, st.o[dt] * alpha);
}

__device__ __forceinline__ void attn_phase(const Args& a, LAS unsigned char* lds, int bid, int G, int tid, int li, int ulo = 0, int uhi = 768) {
    const bf16* QK = (const bf16*)(a.ws + WS_QK); const bf16* VT = (const bf16*)(a.ws + WS_VT); const bf16* CK = (const bf16*)(a.ws + WS_CK); const bf16* CVT = (const bf16*)(a.ws + WS_CVT);
    const bf16* KH = QK + (size_t)T * 2048;
    bf16* AO = (bf16*)(a.ws + WS_AO);
    const int lane = tid & 63, wave = __builtin_amdgcn_readfirstlane(tid >> 6), ln = lane & 15, kg = lane >> 4;
    unsigned kst = (unsigned)((tid >> 4) * AT_KP * 2 + (tid & 15) * 16), vst = (unsigned)AT_KB + (unsigned)((tid >> 3) * AT_VP * 2 + (tid & 7) * 16);
    unsigned kfo = (unsigned)((8 * (ln >> 2) + (ln & 3)) * AT_KP * 2 + kg * 16), vfo = (unsigned)AT_KB + (unsigned)(ln * AT_VP * 2 + kg * 16);
    asm volatile("" : "+v"(kst), "+v"(vst), "+v"(kfo), "+v"(vfo));
    for (int u = ulo + bid; u < uhi; u += G) {
        int h, tq0;
        const bool lat = u >= 512;
        int b = 0, bs = 0, rp2 = 0;
        if (!lat) { b = u >> 5; h = (u >> 1) & 15; tq0 = b * 256 + (u & 1) * 128 + 16 * wave; }
        else { const int v = u - 512; bs = v >> 7; h = (v >> 3) & 15; rp2 = 2 * (v & 7); tq0 = T_P + bs * 1024 + (rp2 + (wave >> 2)) * 64 + 16 * (wave & 3); }
        const int r = rp2 + (wave >> 2);
        bf16x8 qf[4];
#pragma unroll
        for (int c = 0; c < 4; ++c) qf[c] = *(const bf16x8*)(QK + ((size_t)h * T + tq0 + ln) * 128 + 32 * c + 8 * kg);
        AttState st;
#pragma unroll
        for (int dt = 0; dt < 8; ++dt) st.o[dt] = (f32x4){0.f, 0.f, 0.f, 0.f};
        st.m = -1e30f; st.l = 0.f;
        const int cq = wave & 3, row_start = clampi(r - 4, 0, 8), qcol = 16 * cq + ln, col_start = clampi(qcol - 8, 0, 48);
        const int h0 = cq == 3 ? 1 : 0, h1 = cq == 0 ? 1 : 2;
        const int rs0 = clampi(rp2 - 4, 0, 8), nlat = lat ? clampi(rp2 + 1 - 4, 0, 8) + 8 - rs0 : 0, ntile = nlat + 4;
        const size_t cm = ((size_t)bs * 2 + li) * 16 + h;
        auto src_of = [&](int j) -> AttSrc {
            AttSrc t;
            if (!lat) { const int tb = b * 256 + 64 * j; t.kb = KH + ((size_t)h * T + tb) * 128; t.vb = VT + (size_t)(h * 128) * VTP + tb; t.vstride = VTP; }
            else if (j < nlat) { const int tb = T_P + bs * 1024 + (rs0 + j) * 64; t.kb = KH + ((size_t)h * T + tb) * 128; t.vb = VT + (size_t)(h * 128) * VTP + tb; t.vstride = VTP; }
            else { const int kt = j - nlat; t.kb = CK + (cm * 256 + 64 * kt) * 128; t.vb = CVT + cm * 128 * 256 + 64 * kt; t.vstride = 256; }
            return t;
        };
        u32x4 sk[2], sv[2];
        auto stage_load = [&](int j) { const AttSrc t = src_of(j);
#pragma unroll
            for (int q = 0; q < 2; ++q) { sk[q] = *(const u32x4*)((const char*)t.kb + (size_t)(tid + 512 * q) * 16);
                sv[q] = *(const u32x4*)((const char*)t.vb + ((size_t)((tid >> 3) + 64 * q) * t.vstride) * 2 + (tid & 7) * 16); } };
        auto stage_store = [&](int buf) {
#pragma unroll
            for (int q = 0; q < 2; ++q) { *(LAS u32x4*)(lds + buf * AT_STAGE + kst + q * (32 * AT_KP * 2)) = sk[q]; *(LAS u32x4*)(lds + buf * AT_STAGE + vst + q * (64 * AT_VP * 2)) = sv[q]; } };
        __syncthreads();
        if (lat && tid < 15 * 31) { const int dr = tid / 31, dc = tid - dr * 31; ((LAS float*)(lds + AT_RP))[dr * 32 + dc] = a.in[IN_RPB][((size_t)li * 16 + h) * 15 * 31 + tid]; }
        stage_load(0); stage_store(0);
        __syncthreads();
#pragma unroll 1
        for (int j = 0; j < ntile; ++j) {
            const int buf = j & 1;
            if (j + 1 < ntile) stage_load(j + 1);
            const bool islat = lat && j < nlat; const int krow = rs0 + j;
            const bool act = !islat || (krow >= row_start && krow < row_start + 8);
            if (act) {
                const int f0 = islat ? h0 : 0, f1 = islat ? h1 : 2;
                for (int hf = f0; hf < f1; ++hf)
                    attn_half(st, qf, lds, buf * AT_STAGE + kfo + hf * (32 * AT_KP * 2), buf * AT_STAGE + vfo + hf * 64, kg, islat, krow - r + 7, 32 * hf, qcol, col_start);
            }
            if (j + 1 < ntile) stage_store(buf ^ 1);
            __syncthreads();
        }
        const float inv = 1.f / st.l;
        bf16* op = AO + (size_t)(tq0 + ln) * D + h * 128 + 4 * kg;
#pragma unroll
        for (int dt = 0; dt < 8; ++dt) { const f32x4 o = st.o[dt] * inv; u32x2 w; w.x = cvtpk(o[0], o[1]); w.y = cvtpk(o[2], o[3]); *(u32x2*)(op + 16 * dt) = w; }
    }
}

constexpr int GL_QD = 0, GL_KLT = 33792, GL_P = 70656, GL_DEC = 79872, GL_IMG = 80896, GL_KD = 80896, GL_GT = 114688;
constexpr int GL_QS = 264, GL_KLS = 72, GL_PS = 72;
constexpr size_t WS_GIMG = WS_HID;
#define LDSP(T_, off) ((LAS T_*)(lds + (off)))
__device__ __forceinline__ int gla_img_index(int seq, int nc, int hh, int dir) { const int cb = seq < 16 ? 4 * seq : 64 + 16 * (seq - 16); return ((cb + nc) * 4 + hh) * 2 + dir; }

__device__ __forceinline__ void gla_prep_unit(const Args& a, LAS unsigned char* lds, int tid, int li, int seq, int nc, int hh, int dir) {
    const bf16* QK = (const bf16*)(a.ws + WS_QK); const float* TLR = (const float*)(a.ws + WS_TLR);
    const int lane = tid & 63, wave = __builtin_amdgcn_readfirstlane(tid >> 6), ln = lane & 15, kg = lane >> 4;
    const bool lat = seq >= 16;
    const int tok0 = (lat ? T_P + (seq - 16) * 1024 : seq * 256) + nc * 64;
    const int half = lane >> 5, i0 = 2 * (lane & 31), ca = half * 128 + i0;
    unsigned la_w = (unsigned)(8 * wave * GL_QS + ca) * 2u;
    unsigned la_klt = (unsigned)GL_KLT + (unsigned)(ca * GL_KLS + 8 * wave) * 2u;
    unsigned la_gt = (unsigned)GL_GT + (unsigned)ca * 4u;
    unsigned la_dec = (unsigned)GL_DEC + (unsigned)ca * 4u;
    unsigned la_fr = (unsigned)(ln * GL_QS + 8 * kg) * 2u;
    unsigned la_pw = (unsigned)GL_P + (unsigned)(ln * GL_PS + 4 * kg) * 2u;
    asm volatile("" : "+v"(la_w), "+v"(la_klt), "+v"(la_gt), "+v"(la_dec), "+v"(la_fr), "+v"(la_pw));
    const float* w2p = a.in[IN_WA2] + ((size_t)li * 2 + dir) * 16 * 1024 + hh * 256 + ca;
    const float* bap = a.in[IN_BA] + ((size_t)li * 2 + dir) * 1024 + hh * 256 + ca;
    const float bz0 = bap[0], bz1 = bap[1], bz2 = bap[64], bz3 = bap[65];
    const float fr0 = exp2f(-(float)i0 * (13.287712379549449f / 64.f)), fr1 = exp2f(-(float)(i0 + 1) * (13.287712379549449f / 64.f));
    unsigned qk[8][4];
    { const bf16* qp = QK + (size_t)(tok0 + 8 * wave) * 4096 + hh * 256 + ca;
#pragma unroll
      for (int t = 0; t < 8; ++t, qp += 4096) { qk[t][0] = *(const unsigned*)(qp); qk[t][1] = *(const unsigned*)(qp + 64); qk[t][2] = *(const unsigned*)(qp + 1024); qk[t][3] = *(const unsigned*)(qp + 1024 + 64); } }
    float cum[8][4];
    {
        f32x2 za[8], zb[8];
#pragma unroll
        for (int t = 0; t < 8; ++t) { za[t] = (f32x2){bz0, bz1}; zb[t] = (f32x2){bz2, bz3}; }
        const float* wp = w2p; const float* tp = TLR + (size_t)(tok0 + 8 * wave) * 32 + dir * 16;
#pragma unroll 2
        for (int r4 = 0; r4 < 4; ++r4, tp += 4) {
            f32x2 wa[4], wb[4];
#pragma unroll
            for (int rr = 0; rr < 4; ++rr, wp += 1024) { wa[rr] = *(const f32x2*)wp; wb[rr] = *(const f32x2*)(wp + 64); }
#pragma unroll
            for (int t = 0; t < 8; ++t) { const f32x4 tl = *(const f32x4*)(tp + t * 32);
#pragma unroll
                for (int rr = 0; rr < 4; ++rr) { za[t] += wa[rr] * tl[rr]; zb[t] += wb[rr] * tl[rr]; } }
        }
#pragma unroll
        for (int t = 0; t < 8; ++t) { cum[t][0] = za[t][0]; cum[t][1] = za[t][1]; cum[t][2] = zb[t][0]; cum[t][3] = zb[t][1]; }
        float run[4] = {0.f, 0.f, 0.f, 0.f};
        if (dir == 0) {
#pragma unroll
            for (int t = 0; t < 8; ++t)
#pragma unroll
                for (int e = 0; e < 4; ++e) { run[e] += logsigmoid_f(cum[t][e]) * (1.f / 16.f); cum[t][e] = run[e]; }
        } else {
#pragma unroll
            for (int t = 7; t >= 0; --t)
#pragma unroll
                for (int e = 0; e < 4; ++e) { run[e] += logsigmoid_f(cum[t][e]) * (1.f / 16.f); cum[t][e] = run[e]; }
        }
        *LDSP(f32x2, la_gt + wave * 1024) = (f32x2){run[0], run[1]}; *LDSP(f32x2, la_gt + wave * 1024 + 256) = (f32x2){run[2], run[3]};
    }
    __syncthreads();
    {
        float pre[4] = {0.f, 0.f, 0.f, 0.f}, tot[4] = {0.f, 0.f, 0.f, 0.f};
#pragma unroll
        for (int g = 0; g < 8; ++g) { const f32x2 x = *LDSP(f32x2, la_gt + g * 1024), y = *LDSP(f32x2, la_gt + g * 1024 + 256);
            const bool before = dir ? (g > wave) : (g < wave);
            tot[0] += x[0]; tot[1] += x[1]; tot[2] += y[0]; tot[3] += y[1];
            if (before) { pre[0] += x[0]; pre[1] += x[1]; pre[2] += y[0]; pre[3] += y[1]; } }
        float dtot[4];
#pragma unroll
        for (int e = 0; e < 4; ++e) dtot[e] = __expf(tot[e]);
        if (wave == 0) { *LDSP(f32x2, la_dec) = (f32x2){dtot[0], dtot[1]}; *LDSP(f32x2, la_dec + 256) = (f32x2){dtot[2], dtot[3]}; }
        unsigned klp[4][4];
        float klh[4] = {0.f, 0.f, 0.f, 0.f};
#pragma unroll
        for (int t = 0; t < 8; ++t) {
            const unsigned qa = qk[t][0], qb = qk[t][1], ka = qk[t][2], kb2 = qk[t][3];
            float q[4] = {bflo(qa), bfhi(qa), bflo(qb), bfhi(qb)}, k[4] = {bflo(ka), bfhi(ka), bflo(kb2), bfhi(kb2)};
            if (lat) {
                const float pos = (float)(half ? 8 * wave + t : nc);
                float r0 = pos * fr0 * 0.15915494309189535f, r1 = pos * fr1 * 0.15915494309189535f; r0 -= floorf(r0); r1 -= floorf(r1);
                const float s0 = __builtin_amdgcn_sinf(r0), c0 = __builtin_amdgcn_cosf(r0), s1 = __builtin_amdgcn_sinf(r1), c1 = __builtin_amdgcn_cosf(r1);
                const float q0 = q[0] * c0 - q[2] * s0, q2 = q[0] * s0 + q[2] * c0, q1 = q[1] * c1 - q[3] * s1, q3 = q[1] * s1 + q[3] * c1;
                const float k0 = k[0] * c0 - k[2] * s0, k2 = k[0] * s0 + k[2] * c0, k1 = k[1] * c1 - k[3] * s1, k3 = k[1] * s1 + k[3] * c1;
                q[0] = q0; q[1] = q1; q[2] = q2; q[3] = q3; k[0] = k0; k[1] = k1; k[2] = k2; k[3] = k3;
            }
            float qd[4], kd[4];
#pragma unroll
            for (int e = 0; e < 4; ++e) { const float cm = pre[e] + cum[t][e], ec = __expf(cm), ei = __builtin_amdgcn_rcpf(ec); qd[e] = q[e] * 0.0625f * ec; kd[e] = k[e] * ei;
                const float kl = kd[e] * dtot[e]; if (t & 1) klp[e][t >> 1] = cvtpk(klh[e], kl); else klh[e] = kl; }
            *LDSP(unsigned, GL_QD + la_w + t * (GL_QS * 2)) = cvtpk(qd[0], qd[1]); *LDSP(unsigned, GL_QD + la_w + t * (GL_QS * 2) + 128) = cvtpk(qd[2], qd[3]);
            *LDSP(unsigned, GL_KD + la_w + t * (GL_QS * 2)) = cvtpk(kd[0], kd[1]); *LDSP(unsigned, GL_KD + la_w + t * (GL_QS * 2) + 128) = cvtpk(kd[2], kd[3]);
        }
#pragma unroll
        for (int e = 0; e < 4; ++e) { const int coff = ((e < 2 ? 0 : 64) + (e & 1)) * GL_KLS * 2;
            u32x4 w; w.x = klp[e][0]; w.y = klp[e][1]; w.z = klp[e][2]; w.w = klp[e][3];
            *LDSP(u32x4, la_klt + coff) = w; }
    }
    __syncthreads();
#pragma unroll
    for (int j = 0; j < 2; ++j) { const int idx = 2 * wave + j, sb = idx >> 2, tbk = idx & 3;
        f32x4 acc = {0.f, 0.f, 0.f, 0.f};
        const unsigned ka_ = GL_KD + la_fr + sb * (16 * GL_QS * 2), qa_ = GL_QD + la_fr + tbk * (16 * GL_QS * 2);
#pragma unroll
        for (int c = 0; c < 8; ++c) { const bf16x8 af = *LDSP(const bf16x8, ka_ + 64 * c), bfr = *LDSP(const bf16x8, qa_ + 64 * c); acc = MFMA16(af, bfr, acc); }
        const int t = 16 * tbk + ln;
        float pv[4];
#pragma unroll
        for (int i = 0; i < 4; ++i) { const int s = 16 * sb + 4 * kg + i; const bool keep = dir ? (s >= t) : (s <= t); pv[i] = keep ? acc[i] : 0.f; }
        u32x2 w; w.x = cvtpk(pv[0], pv[1]); w.y = cvtpk(pv[2], pv[3]);
        *LDSP(u32x2, la_pw + tbk * (16 * GL_PS * 2) + sb * 32) = w; }
    __syncthreads();
    {
        unsigned char* img = a.ws + WS_GIMG + (size_t)gla_img_index(seq, nc, hh, dir) * GL_IMG;
#pragma unroll
        for (int j = 0; j < 10; ++j) { const int pc = tid + 512 * j; if (pc < GL_IMG / 16) *(u32x4*)(img + (size_t)pc * 16) = *LDSP(const u32x4, pc * 16); }
    }
    __syncthreads();
}

__device__ __forceinline__ void gla_prep_phase(const Args& a, LAS unsigned char* lds, int bid, int G, int tid, int li) {
    for (int u = bid; u < 768; u += G) { const int dir = u & 1, hh = (u >> 1) & 3, cpos = u >> 3;
        const int seq = cpos < 64 ? cpos >> 2 : 16 + ((cpos - 64) >> 4), nc = cpos < 64 ? cpos & 3 : (cpos - 64) & 15;
        gla_prep_unit(a, lds, tid, li, seq, nc, hh, dir); }
}

__device__ __forceinline__ void gla_scan_unit(const Args& a, LAS unsigned char* lds, int tid, int li, int seq, int hh, int dir, int dvs) {
    const bf16* VT = (const bf16*)(a.ws + WS_VT); float* OG = (float*)(a.ws + WS_OG);
    const int lane = tid & 63, wave = __builtin_amdgcn_readfirstlane(tid >> 6), ln = lane & 15, kg = lane >> 4;
    const bool lat = seq >= 16;
    const int tb = lat ? T_P + (seq - 16) * 1024 : seq * 256, nch = lat ? 16 : 4;
    unsigned la_fr = (unsigned)GL_QD + (unsigned)(ln * GL_QS + 8 * kg) * 2u;
    unsigned la_p = (unsigned)GL_P + (unsigned)(ln * GL_PS + 8 * kg) * 2u;
    unsigned la_kr = (unsigned)GL_KLT + (unsigned)((8 * (ln >> 2) + (ln & 3)) * GL_KLS + 8 * kg) * 2u;
    unsigned la_dr = (unsigned)GL_DEC + (unsigned)(8 * kg) * 4u;
    unsigned la_cp = (unsigned)tid * 16u;
    asm volatile("" : "+v"(la_fr), "+v"(la_p), "+v"(la_kr), "+v"(la_dr), "+v"(la_cp));
    const int dvcol = dvs * 128 + 16 * wave + ln;
    f32x4 Sacc[8][2];
    if (lat) { const float* sp = a.in[IN_SG] + ((((size_t)(seq - 16) * 2 + li) * 2 + dir) * 4 + hh) * 256 * 512 + dvcol + (size_t)(8 * kg) * 512;
#pragma unroll
        for (int c = 0; c < 8; ++c)
#pragma unroll
            for (int s = 0; s < 2; ++s)
#pragma unroll
                for (int i = 0; i < 4; ++i) Sacc[c][s][i] = sp[(size_t)(32 * c + 4 * s + i) * 512];
    } else {
#pragma unroll
        for (int c = 0; c < 8; ++c)
#pragma unroll
            for (int s = 0; s < 2; ++s) Sacc[c][s] = (f32x4){0.f, 0.f, 0.f, 0.f};
    }
    const bf16* vrow = VT + (size_t)(hh * 512 + dvcol) * VTP + 8 * kg;
    const unsigned char* imgs = a.ws + WS_GIMG;
    u32x4 stg[10]; bf16x8 vfn[2];
    { const int nc = dir ? nch - 1 : 0; const unsigned char* img = imgs + (size_t)gla_img_index(seq, nc, hh, dir) * GL_IMG + la_cp;
#pragma unroll
      for (int j = 0; j < 10; ++j) if (j < 9 || tid < (GL_IMG / 16 - 9 * 512)) stg[j] = *(const u32x4*)(img + (size_t)j * 8192);
#pragma unroll
      for (int c = 0; c < 2; ++c) vfn[c] = *(const bf16x8*)(vrow + tb + nc * 64 + 32 * c); }
#pragma unroll 1
    for (int p = 0; p < nch; ++p) {
        const int nc = dir ? nch - 1 - p : p, tok0 = tb + nc * 64;
#pragma unroll
        for (int j = 0; j < 10; ++j) if (j < 9 || tid < (GL_IMG / 16 - 9 * 512)) *LDSP(u32x4, la_cp + j * 8192) = stg[j];
        bf16x8 vf[2] = {vfn[0], vfn[1]};
        __syncthreads();
        if (p + 1 < nch) { const int nn = dir ? nch - 2 - p : p + 1; const unsigned char* img = imgs + (size_t)gla_img_index(seq, nn, hh, dir) * GL_IMG + la_cp;
#pragma unroll
            for (int j = 0; j < 10; ++j) if (j < 9 || tid < (GL_IMG / 16 - 9 * 512)) stg[j] = *(const u32x4*)(img + (size_t)j * 8192);
#pragma unroll
            for (int c = 0; c < 2; ++c) vfn[c] = *(const bf16x8*)(vrow + tb + nn * 64 + 32 * c); }
        {
            bf16x8 sf[8];
#pragma unroll
            for (int c = 0; c < 8; ++c) { u32x4 w; w.x = cvtpk(Sacc[c][0][0], Sacc[c][0][1]); w.y = cvtpk(Sacc[c][0][2], Sacc[c][0][3]); w.z = cvtpk(Sacc[c][1][0], Sacc[c][1][1]); w.w = cvtpk(Sacc[c][1][2], Sacc[c][1][3]);
                sf[c] = __builtin_bit_cast(bf16x8, w); }
            const size_t ogi = (size_t)dir * T * D + (size_t)(tok0 + ln) * D + hh * 512 + dvs * 128 + 16 * wave + 4 * kg;
#pragma unroll
            for (int tt = 0; tt < 4; ++tt) {
                f32x4 o = {0.f, 0.f, 0.f, 0.f};
#pragma unroll
                for (int c = 0; c < 2; ++c) { const bf16x8 pf = *LDSP(const bf16x8, la_p + tt * (16 * GL_PS * 2) + 64 * c); o = MFMA16(vf[c], pf, o); }
#pragma unroll
                for (int c = 0; c < 8; ++c) { const bf16x8 qf = *LDSP(const bf16x8, la_fr + tt * (16 * GL_QS * 2) + 64 * c); o = MFMA16(sf[c], qf, o); }
                if (OG_BF16) { u32x2 w; w.x = cvtpk(o[0], o[1]); w.y = cvtpk(o[2], o[3]); *(u32x2*)((bf16*)OG + ogi + (size_t)(16 * tt) * D) = w; }
                else *(f32x4*)(OG + ogi + (size_t)(16 * tt) * D) = o;
            }
#pragma unroll
            for (int c = 0; c < 8; ++c)
#pragma unroll
                for (int s = 0; s < 2; ++s) {
                    const f32x4 dc = *LDSP(const f32x4, la_dr + (32 * c + 4 * s) * 4);
                    f32x4 acc = Sacc[c][s] * dc;
#pragma unroll
                    for (int c2 = 0; c2 < 2; ++c2) { const bf16x8 kf = *LDSP(const bf16x8, la_kr + (32 * c + 4 * s) * (GL_KLS * 2) + 64 * c2); acc = MFMA16(kf, vf[c2], acc); }
                    Sacc[c][s] = acc;
                }
        }
        __syncthreads();
    }
    if (!lat) { float* sp = a.out + OUT_GLA + ((((size_t)seq * 2 + li) * 2 + dir) * 4 + hh) * 256 * 512 + dvcol + (size_t)(8 * kg) * 512;
#pragma unroll
        for (int c = 0; c < 8; ++c)
#pragma unroll
            for (int s = 0; s < 2; ++s)
#pragma unroll
                for (int i = 0; i < 4; ++i) sp[(size_t)(32 * c + 4 * s + i) * 512] = Sacc[c][s][i];
    }
}

__device__ __forceinline__ void gla_scan_phase(const Args& a, LAS unsigned char* lds, int bid, int G, int tid, int li) {
    if (G > 64) {
        if (bid < 64) { const int u = bid; gla_scan_unit(a, lds, tid, li, 16 + (u >> 5), (u >> 3) & 3, (u >> 2) & 1, u & 3); }
        else for (int u = bid - 64; u < 512; u += G - 64) gla_scan_unit(a, lds, tid, li, u >> 5, (u >> 3) & 3, (u >> 2) & 1, u & 3);
    } else {
        for (int u = bid; u < 576; u += G) gla_scan_unit(a, lds, tid, li, u >> 5, (u >> 3) & 3, (u >> 2) & 1, u & 3);
    }
}
#undef LDSP

#ifndef PROBE_DOUBLE
#define PROBE_DOUBLE 0
#endif
#ifndef STAGGER
#define STAGGER 0
#endif
#ifndef W2_SPLITK
#define W2_SPLITK 0
#endif
constexpr int LDS_BYTES = 147456;
constexpr int MISC_OFF = 131072 + 320;

__global__ void __launch_bounds__(512, 2) mega_fwd(Args a) {
    extern __shared__ __attribute__((aligned(16))) unsigned char lds_raw[];
    LAS unsigned char* lds = (LAS unsigned char*)lds_raw;
    volatile LAS unsigned* MISC = (volatile LAS unsigned*)(lds + MISC_OFF);
    const int G = gridDim.x, bid = blockIdx.x;
    for (int u = threadIdx.x; u < (LDS_BYTES - 131072) / 4; u += 512) ((LAS unsigned*)(lds + 131072))[u] = 0u;
    __syncthreads();
    unsigned* ctl = (unsigned*)(a.ws + WS_CTL);
    const int lo = a.ph_lo, hi = a.ph_hi;
    XcdBarrier bar = xcd_barrier_post(ctl + CW_BAR + lo * XCD_BAR_WORDS, MISC + 8);
#define IN(k) (lo <= (k) && (k) < hi)
#define SEAM(k) do { if (IN(k) && IN((k) + 1)) { xcd_barrier(bar); if (PROBE_DOUBLE & 16) xcd_barrier(bar); } } while (0)
    const int ngw = G * 8;
#define LANEVARS int tid = threadIdx.x; asm volatile("" : "+v"(tid)); const int lane = tid & 63, wave = __builtin_amdgcn_readfirstlane(tid >> 6), gw = bid * 8 + wave; (void)lane; (void)gw
    unsigned char* ws = a.ws;
    const float* MOD = (const float*)(ws + WS_MOD);
    const float* NG = a.in[IN_NORMG];
    bf16* H = (bf16*)(ws + WS_H); bf16* QK = (bf16*)(ws + WS_QK); bf16* VT = (bf16*)(ws + WS_VT); bf16* AO = (bf16*)(ws + WS_AO); bf16* HID = (bf16*)(ws + WS_HID);
    float* Y = (float*)(ws + WS_Y); float* TLR = (float*)(ws + WS_TLR);

    if (IN(PH_PRO)) { LANEVARS; prologue_phase(a, lds, bid, G, tid); if (PROBE_DOUBLE & 8) { __syncthreads(); prologue_phase(a, lds, bid, G, tid); } }
    SEAM(PH_PRO);
    if (IN(PH_R0)) { LANEVARS; row_phase<true, false, true>(a, gw, ngw, lane, nullptr, nullptr, 0, NG + 0 * D, MOD, 0, 1); }
    SEAM(PH_R0);

    for (int l = 0; l < NL; ++l) {
        const int pb = PH_L0 + l * PH_PER_LAYER, li = l >> 1;
        const bool gla = l & 1;
        const bf16* Wmix = (const bf16*)(ws + WS_WMIX) + (size_t)l * NMIX * D;
        const float* MODl = MOD + (size_t)l * 3 * 12288;
        for (int rep = 0; rep < ((PROBE_DOUBLE & (1 | 2048)) ? 2 : 1); ++rep)
        if (IN(pb + LP_MIX)) {
            if (!gla) {
                { pg8::Gemm g{H, Wmix, T, NQK_NA, D}; pg8::StaticOrder S; S.init(T, NQK_NA, G, bid);
                  EpiWrap<E8NaQK> E{{QK, a.out + OUT_NK, li}}; pg8::gemm_phase<EpiWrap<E8NaQK>, pg8::StaticOrder, false, true>(lds, g, S, E); }
                { pg8::Gemm g{Wmix + (size_t)NQK_NA * D, H, 2048, T, D}; pg8::StaticOrder S; S.init(2048, T, G, (bid + 128) % G);
                  EpiWrap<E8VT> E{{VT, a.out + OUT_NV, li}}; pg8::gemm_phase<EpiWrap<E8VT>, pg8::StaticOrder, false, true>(lds, g, S, E); }
            } else {
                { pg8::Gemm g{H, Wmix, T, NQK_GLA, D}; pg8::StaticOrder S; S.init(T, NQK_GLA, G, bid);
                  EpiWrap<E8GlaQKG> E{{QK, TLR}}; pg8::gemm_phase<EpiWrap<E8GlaQKG>, pg8::StaticOrder, false, true>(lds, g, S, E); }
                { pg8::Gemm g{Wmix + (size_t)NQK_GLA * D, H, 2048, T, D}; pg8::StaticOrder S; S.init(2048, T, G, (bid + 104) % G);
                  EpiWrap<E8VT> E{{VT, nullptr, 0}}; pg8::gemm_phase<EpiWrap<E8VT>, pg8::StaticOrder, false, true>(lds, g, S, E); }
            }
        }
        if (IN(pb + LP_MIX) && l + 1 < NL) {
            const int first = gla ? 88 : 64;
            if (G == 256 && bid >= first) { LANEVARS; if (ADA_DEFER) { __syncthreads(); silu_table(a, lds, tid); ada_layer(a, lds, l + 1, bid - first, G - first, tid); } convert_weights(a, lds, l + 1, 0, CV_MIX_END, bid - first, G - first, tid); }
        }
        SEAM(pb + LP_MIX);
        if (IN(pb + LP_CORE)) {
            LANEVARS; if (!gla) { attn_phase(a, lds, bid, G, tid, li); if (PROBE_DOUBLE & 2) attn_phase(a, lds, bid, G, tid, li); if (PROBE_DOUBLE & 64) attn_phase(a, lds, bid, G, tid, li, 0, 512); if (PROBE_DOUBLE & 128) attn_phase(a, lds, bid, G, tid, li, 512, 768); }
            else { gla_prep_phase(a, lds, bid, G, tid, li); if (PROBE_DOUBLE & 32) gla_prep_phase(a, lds, bid, G, tid, li);
                   xcd_barrier(bar);
                   gla_scan_phase(a, lds, bid, G, tid, li); if (PROBE_DOUBLE & 4) gla_scan_phase(a, lds, bid, G, tid, li); }
        }
        SEAM(pb + LP_CORE);
        if (gla) {
            if (IN(pb + LP_GATE)) { LANEVARS; gla_gate_phase(a, gw, ngw, lane, li); }
            SEAM(pb + LP_GATE);
        }
        for (int rep = 0; rep < ((PROBE_DOUBLE & (1 | 1024)) ? 2 : 1); ++rep)
        if (IN(pb + LP_WO)) {
            if (l + 1 < NL && G == 256 && bid >= 192) { LANEVARS; convert_weights(a, lds, l + 1, CV_MIX_END, CV_WO_END, bid - 192, G - 192, tid); }
            pg8::Gemm g{AO, (const bf16*)(ws + WS_WO) + (size_t)l * D * D, T, D, D}; pg8::StaticOrder S; S.init(T, D, G, bid);
            if (Y_BF16) { EpiWrap<E8Bf16> E{{(bf16*)Y, D}}; pg8::gemm_phase<EpiWrap<E8Bf16>, pg8::StaticOrder, false, true>(lds, g, S, E); }
            else { EpiWrap<E8F32> E{{Y, D}}; pg8::gemm_phase<EpiWrap<E8F32>, pg8::StaticOrder, false, true>(lds, g, S, E); }
        }
        SEAM(pb + LP_WO);
        if (IN(pb + LP_ROWMID)) { LANEVARS; row_phase<false, true, true>(a, gw, ngw, lane, NG + ((size_t)l * 4 + 1) * D, MODl, 2, NG + ((size_t)l * 4 + 2) * D, MODl, 3, 4); }
        SEAM(pb + LP_ROWMID);
        for (int rep = 0; rep < ((PROBE_DOUBLE & (1 | 256)) ? 2 : 1); ++rep)
        if (IN(pb + LP_W1)) {
            if (STAGGER) { const int pos = (bid >> 3) & 31; for (int i = 0; i < pos; ++i) __builtin_amdgcn_s_sleep(STAGGER); }
            pg8::Gemm g{H, (const bf16*)(ws + WS_W1) + (size_t)l * FF * D, T, FF, D}; pg8::StaticOrder S; S.init(T, FF, G, bid);
            EpiWrap<E8Relu2> E{{HID, FF}}; pg8::gemm_phase<EpiWrap<E8Relu2>, pg8::StaticOrder, false, true>(lds, g, S, E);
        }
        SEAM(pb + LP_W1);
        for (int rep = 0; rep < ((PROBE_DOUBLE & (1 | 512)) ? 2 : 1); ++rep)
        if (IN(pb + LP_W2)) {
            constexpr int W2_UNITS = (T / 256) * (D / 256);
            if (!W2_SPLITK && l + 1 < NL && G == 256 && bid >= W2_UNITS) { LANEVARS; convert_weights(a, lds, l + 1, CV_WO_END, CV_W2_END, bid - W2_UNITS, G - W2_UNITS, tid); }

            pg8::Gemm g{HID, (const bf16*)(ws + WS_W2) + (size_t)l * D * FF, T, D, FF};
            EpiF32Part E{Y, Y + (size_t)T * D};
            if (G == 256 && W2_SPLITK) { SplitKOrder S{bid}; pg8::gemm_phase<EpiF32Part, SplitKOrder, true, true>(lds, g, S, E); }
            else if (Y_BF16) { pg8::StaticOrder S; S.init(T, D, G, bid); EpiWrap<E8Bf16> E2{{(bf16*)Y, D}}; pg8::gemm_phase<EpiWrap<E8Bf16>, pg8::StaticOrder, false, true>(lds, g, S, E2); }
            else { pg8::StaticOrder S; S.init(T, D, G, bid); pg8::gemm_phase<EpiF32Part, pg8::StaticOrder, false, true>(lds, g, S, E); }
        }
        SEAM(pb + LP_W2);
        if (IN(pb + LP_ROWEND)) {
            LANEVARS;
            if (G == 256 && W2_SPLITK) {
                if (l < NL - 1) row_phase<false, true, true, true>(a, gw, ngw, lane, NG + ((size_t)l * 4 + 3) * D, MODl, 5, NG + ((size_t)(l + 1) * 4 + 0) * D, MODl + 3 * 12288, 0, 1);
                else            row_phase<false, true, false, true>(a, gw, ngw, lane, NG + ((size_t)l * 4 + 3) * D, MODl, 5, nullptr, nullptr, 0, 0);
            } else {
                if (l < NL - 1) row_phase<false, true, true>(a, gw, ngw, lane, NG + ((size_t)l * 4 + 3) * D, MODl, 5, NG + ((size_t)(l + 1) * 4 + 0) * D, MODl + 3 * 12288, 0, 1);
                else            row_phase<false, true, false>(a, gw, ngw, lane, NG + ((size_t)l * 4 + 3) * D, MODl, 5, nullptr, nullptr, 0, 0);
            }
        }
        SEAM(pb + LP_ROWEND);
    }
#undef IN
#undef SEAM
#undef LANEVARS
}

static void launch_range(const Args& base, int lo, int hi, int grid, hipStream_t stream) {
    if (lo >= hi) return;
    Args a = base; a.ph_lo = lo; a.ph_hi = hi;
    hipLaunchKernelGGL(mega_fwd, dim3(grid), dim3(512), LDS_BYTES, stream, a);
    const hipError_t le = hipPeekAtLastError();
    if (le != hipSuccess) fprintf(stderr, "kernel_launch: mega_fwd [%d,%d) failed: %s\n", lo, hi, hipGetErrorName(le));
}
template <class E8> static void launch_ref_gemm(const bf16* A, const bf16* Bt, int M, int N, int K, const E8& E, hipStream_t stream) {
    hipLaunchKernelGGL((ref_gemm<E8>), dim3(N / 64, M / 64), dim3(256), 0, stream, A, Bt, M, N, K, E);
}

extern "C" void kernel_launch(void* const* d_in, const int* in_sizes, int n_in, void* d_out, int out_size, void* d_ws, size_t ws_size, hipStream_t stream) {
    static int grid = 0;
    if (grid == 0) {
        if (n_in != 21 || (size_t)out_size != OUT_TOTAL || ws_size < WS_END) { fprintf(stderr, "kernel_launch: unexpected shapes (n_in %d out %d ws %zu)\n", n_in, out_size, ws_size); grid = -1; return; }
        int dev = 0, cus = 0, per_cu = 0;
        if (hipGetDevice(&dev) != hipSuccess || hipDeviceGetAttribute(&cus, hipDeviceAttributeMultiprocessorCount, dev) != hipSuccess) { grid = -1; return; }
        if (hipFuncSetAttribute((const void*)mega_fwd, hipFuncAttributeMaxDynamicSharedMemorySize, LDS_BYTES) != hipSuccess) { fprintf(stderr, "kernel_launch: hipFuncSetAttribute failed\n"); grid = -1; return; }
        if (hipOccupancyMaxActiveBlocksPerMultiprocessor(&per_cu, (const void*)mega_fwd, 512, LDS_BYTES) != hipSuccess || per_cu < 1) fprintf(stderr, "kernel_launch: occupancy query says %d\n", per_cu);
        (void)hipGetLastError();
        grid = cus;
    }
    if (grid < 0) return;
    (void)hipMemsetAsync((char*)d_ws + WS_CTL, 0, CTL_ZERO_BYTES, stream);
    Args a{};
    for (int i = 0; i < 21; ++i) a.in[i] = (const float*)d_in[i];
    a.out = (float*)d_out; a.ws = (unsigned char*)d_ws;
#if CFG_ONE_LAUNCH && !CFG_NAIVE_GEMM && !CFG_NAIVE_ATTN && !CFG_NAIVE_GLA
    launch_range(a, 0, NPH, grid, stream);
#else
    unsigned char* ws = (unsigned char*)d_ws;
    bf16* H = (bf16*)(ws + WS_H); bf16* QK = (bf16*)(ws + WS_QK); bf16* VT = (bf16*)(ws + WS_VT); bf16* AO = (bf16*)(ws + WS_AO); bf16* HID = (bf16*)(ws + WS_HID);
    float* Y = (float*)(ws + WS_Y); float* TLR = (float*)(ws + WS_TLR);
    launch_range(a, PH_PRO, PH_PRO + 1, grid, stream);
    launch_range(a, PH_R0, PH_R0 + 1, grid, stream);
    for (int l = 0; l < NL; ++l) {
        const int pb = PH_L0 + l * PH_PER_LAYER, li = l >> 1; const bool gla = l & 1;
        const bf16* Wmix = (const bf16*)(ws + WS_WMIX) + (size_t)l * NMIX * D;
        if (CFG_NAIVE_GEMM) {
            if (!gla) { launch_ref_gemm(H, Wmix, T, NQK_NA, D, E8NaQK{QK, a.out + OUT_NK, li}, stream); launch_ref_gemm(Wmix + (size_t)NQK_NA * D, H, 2048, T, D, E8VT{VT, a.out + OUT_NV, li}, stream); }
            else { launch_ref_gemm(H, Wmix, T, NQK_GLA, D, E8GlaQKG{QK, TLR}, stream); launch_ref_gemm(Wmix + (size_t)NQK_GLA * D, H, 2048, T, D, E8VT{VT, nullptr, 0}, stream); }
        } else launch_range(a, pb + LP_MIX, pb + LP_MIX + 1, grid, stream);
        if (!gla) { if (CFG_NAIVE_ATTN) hipLaunchKernelGGL(ref_attn, dim3(T * 16), dim3(128), 0, stream, a, li); else launch_range(a, pb + LP_CORE, pb + LP_CORE + 1, grid, stream); }
        else { if (CFG_NAIVE_GLA) hipLaunchKernelGGL(ref_gla, dim3(18 * 4 * 2 * 64), dim3(256), 0, stream, a, li); else launch_range(a, pb + LP_CORE, pb + LP_CORE + 1, grid, stream);
               launch_range(a, pb + LP_GATE, pb + LP_GATE + 1, grid, stream); }
        if (CFG_NAIVE_GEMM) launch_ref_gemm(AO, (const bf16*)(ws + WS_WO) + (size_t)l * D * D, T, D, D, E8F32{Y, D}, stream); else launch_range(a, pb + LP_WO, pb + LP_WO + 1, grid, stream);
        launch_range(a, pb + LP_ROWMID, pb + LP_ROWMID + 1, grid, stream);
        if (CFG_NAIVE_GEMM) launch_ref_gemm(H, (const bf16*)(ws + WS_W1) + (size_t)l * FF * D, T, FF, D, E8Relu2{HID, FF}, stream); else launch_range(a, pb + LP_W1, pb + LP_W1 + 1, grid, stream);
        if (CFG_NAIVE_GEMM) launch_ref_gemm(HID, (const bf16*)(ws + WS_W2) + (size_t)l * D * FF, T, D, FF, E8F32{Y, D}, stream); else launch_range(a, pb + LP_W2, pb + LP_W2 + 1, grid, stream);
        launch_range(a, pb + LP_ROWEND, pb + LP_ROWEND + 1, grid, stream);
    }
#endif
}
```

```cpp
#include <hip/hip_runtime.h>
#include <cstdio>
#include <cstdint>

#ifndef CFG_NAIVE_GEMM
#define CFG_NAIVE_GEMM 0
#endif
#ifndef CFG_NAIVE_ATTN
#define CFG_NAIVE_ATTN 0
#endif
#ifndef CFG_NAIVE_GLA
#define CFG_NAIVE_GLA 0
#endif
#ifndef Y_BF16
#define Y_BF16 1
#endif
#ifndef OG_BF16
#define OG_BF16 1
#endif
#ifndef CFG_ONE_LAUNCH
#define CFG_ONE_LAUNCH 1
#endif

#define GAS __attribute__((address_space(1)))
#define LAS __attribute__((address_space(3)))
typedef unsigned short bf16;
typedef float f32x4 __attribute__((ext_vector_type(4)));
typedef float f32x2 __attribute__((ext_vector_type(2)));
typedef short bf16x8 __attribute__((ext_vector_type(8)));
typedef short bf16x4 __attribute__((ext_vector_type(4)));
typedef unsigned u32x4 __attribute__((ext_vector_type(4)));
typedef unsigned u32x2 __attribute__((ext_vector_type(2)));

constexpr int D = 2048, T_P = 4096, T_S = 2048, T = 6144, FF = 8192, NL = 4;
constexpr int NMIX = 6400;
constexpr int NQK_NA = 4096, NQK_GLA = 4352;
constexpr float EPS = 1e-6f;
constexpr float LOG2E = 1.4426950408889634f;

constexpr size_t MiB = 1u << 20;
constexpr size_t WS_CTL = 0, CTL_ZERO_BYTES = 1 * MiB;
constexpr size_t WS_MOD = 1 * MiB;
constexpr size_t WS_WMIX = 2 * MiB;
constexpr size_t WS_WO = 102 * MiB;
constexpr size_t WS_W1 = 134 * MiB;
constexpr size_t WS_W2 = 262 * MiB;
constexpr size_t WS_CK = 390 * MiB;
constexpr size_t WS_CVT = 394 * MiB;
constexpr size_t WS_H = 398 * MiB;
constexpr size_t WS_QK = 422 * MiB;
constexpr int VTP = T + 64;
constexpr size_t WS_VT = 470 * MiB;
constexpr size_t WS_TLR = 496 * MiB;
constexpr size_t WS_AO = 497 * MiB;
constexpr size_t WS_OG = 521 * MiB;
constexpr size_t WS_Y = 617 * MiB;
constexpr size_t WS_HID = 713 * MiB;
constexpr size_t WS_END = 809 * MiB;
constexpr int CW_BAR = 4096;

constexpr size_t OUT_X = 0;
constexpr size_t OUT_NK = 12582912, OUT_NV = 29360128, OUT_GLA = 46137344, OUT_TOTAL = 79691776;

__device__ __forceinline__ unsigned f2bf(float f) { unsigned u = __builtin_bit_cast(unsigned, f); return (u + 0x7fffu + ((u >> 16) & 1u)) >> 16; }
__device__ __forceinline__ unsigned pk2(float lo, float hi) { return f2bf(lo) | (f2bf(hi) << 16); }
__device__ __forceinline__ float bf2f(unsigned short b) { return __builtin_bit_cast(float, ((unsigned)b) << 16); }
__device__ __forceinline__ float bflo(unsigned w) { return __builtin_bit_cast(float, w << 16); }
__device__ __forceinline__ float bfhi(unsigned w) { return __builtin_bit_cast(float, w & 0xffff0000u); }
#define LDS_WAIT() asm volatile("s_waitcnt lgkmcnt(0)" ::: "memory")
#define VM_WAIT() asm volatile("s_waitcnt vmcnt(0)" ::: "memory")

namespace pg8 {
#define PG8_LAS __attribute__((address_space(3)))
typedef unsigned short bf16_t;
typedef short bf16x8 __attribute__((ext_vector_type(8)));
typedef float f32x4 __attribute__((ext_vector_type(4)));
typedef unsigned u32x4 __attribute__((ext_vector_type(4)));
constexpr int BM = 256, BK = 64, HALF = 128, HTB = HALF * BK * 2  , STAGE_BYTES = 8 * HTB, NXCD = 8, WGM = 8;

__host__ __device__ __forceinline__ int lds_byte(int r, int c) { const int st = (r >> 4) * 2 + (c >> 5), rr = r & 15, cc = c & 31, ob = rr * 64 + cc * 2; return st * 1024 + (ob ^ (((ob >> 9) & 1) << 5)); }
__host__ __device__ __forceinline__ void stage_rc(int b, int& R, int& C) { const int st = b / 1024, sb = b % 1024, swz = sb ^ (((sb >> 9) & 1) << 5); R = (st >> 1) * 16 + swz / 64; C = (st & 1) * 32 + (swz % 64) / 2; }
__host__ __device__ __forceinline__ int perm32(int rho) { const int n = rho >> 4, i = rho & 15; return 8 * (i >> 2) + 4 * n + (i & 3); }

struct Unit { int pm, pn, k0, nt, part; };
struct Gemm { const bf16_t* A; const bf16_t* Bt; int M, N, K; };

struct StaticOrder {
    int nM, nN, nwg, G, c;
    __host__ __device__ void init(int M, int N, int G_, int c_) { nM = M / BM; nN = N / BM; nwg = nM * nN; G = G_; c = c_; }
    __host__ __device__ bool next(int i, Unit& u) const {
        const long L = (long)i * G + c; if (L >= nwg) return false;
        int wgid = (int)L; { const int q = nwg / NXCD, r = nwg % NXCD, xcd = wgid % NXCD, off = wgid / NXCD; wgid = (xcd < r ? xcd * (q + 1) : r * (q + 1) + (xcd - r) * q) + off; }
        const int nig = WGM * nN, gid = wgid / nig, fm = gid * WGM, gsz = (nM - fm) < WGM ? (nM - fm) : WGM;
        u.pm = fm + ((wgid % nig) % gsz); u.pn = (wgid % nig) / gsz; u.k0 = 0; u.nt = 0; u.part = 0; return true;
    }
    __device__ __forceinline__ void a_ready(const Unit&) const {}
    __device__ __forceinline__ void done(const Unit&) const {}
};

__device__ __forceinline__ unsigned cvt_pk_bf16(float lo, float hi) { unsigned r; asm volatile("v_cvt_pk_bf16_f32 %0, %1, %2" : "=v"(r) : "v"(lo), "v"(hi)); return r; }

template <class Epi, class Sched, bool ALIGN_EPI = false, bool SP2 = false>
__device__ __forceinline__ void gemm_phase(PG8_LAS unsigned char* lds, const Gemm g, const Sched& S, const Epi& E) {
    int tid_l = threadIdx.x; asm volatile("" : "+v"(tid_l)); const int tid = tid_l, wid = __builtin_amdgcn_readfirstlane(tid >> 6), lane = tid & 63, wr = wid >> 2, wc = wid & 3, fr = lane & 15, fq = lane >> 4;
    const int K = g.K;
    unsigned voffA[2], voffB[2];
#pragma unroll
    for (int i = 0; i < 2; ++i) { int R, C; stage_rc(tid * 16 + i * 8192, R, C); const int Rb = Epi::PERM ? ((R & ~31) + perm32(R & 31)) : R;
        voffA[i] = (unsigned)(R * K + C) * 2u; voffB[i] = (unsigned)(Rb * K + C) * 2u; }
    const size_t kstep = (size_t)(BK * 2);
    const size_t hstep = (size_t)HALF * K * 2;
    const size_t tstep = 2 * hstep;
    const unsigned ldsw = (unsigned)wid * 1024u;
    const int aoff = lds_byte(wr * 64 + fr, fq * 8), boff = lds_byte(wc * 32 + fr, fq * 8);
#define PG8_SA(b, h) (((b) * 2 + (h)) * HTB)
#define PG8_SB(b, h) ((4 + (b) * 2 + (h)) * HTB)
#define PG8_STAGE(bufoff, gbase, voff) do { _Pragma("unroll") for (int _i = 0; _i < 2; ++_i) \
        __builtin_amdgcn_global_load_lds((const unsigned*)((const char*)(gbase) + (voff)[_i]), (PG8_LAS unsigned*)(lds + (bufoff) + ldsw + _i * 8192), 16, 0, 0); } while (0)
#define PG8_LDA(dst, b, h) do { _Pragma("unroll") for (int m = 0; m < 4; ++m) _Pragma("unroll") for (int k = 0; k < 2; ++k) dst[m][k] = *(const PG8_LAS bf16x8*)(lds + PG8_SA(b, h) + aoff + m * 2048 + k * 1024); } while (0)
#define PG8_LDB(dst, b, h) do { _Pragma("unroll") for (int n = 0; n < 2; ++n) _Pragma("unroll") for (int k = 0; k < 2; ++k) dst[n][k] = *(const PG8_LAS bf16x8*)(lds + PG8_SB(b, h) + boff + n * 2048 + k * 1024); } while (0)
#define PG8_MMA(ai, bj, At, Bt) do { __builtin_amdgcn_s_setprio(1); _Pragma("unroll") for (int m = 0; m < 4; ++m) _Pragma("unroll") for (int n = 0; n < 2; ++n) _Pragma("unroll") for (int k = 0; k < 2; ++k) \
        acc[ai][bj][m][n] = __builtin_amdgcn_mfma_f32_16x16x32_bf16(Bt[n][k], At[m][k], acc[ai][bj][m][n], 0, 0, 0); __builtin_amdgcn_s_setprio(0); } while (0)
#define PG8_WAIT_V(n) asm volatile("s_waitcnt vmcnt(" #n ")" ::: "memory")
#define PG8_WAIT_L(n) asm volatile("s_waitcnt lgkmcnt(" #n ")" ::: "memory")
#define PG8_BAR __builtin_amdgcn_s_barrier()
#define PG8_SCHED __builtin_amdgcn_sched_barrier(0)
    Unit cur, nxt; int ui = 0;
    if (!S.next(0, cur)) return;
    f32x4 acc[2][2][4][2];
#pragma unroll
    for (int a = 0; a < 2; ++a)
#pragma unroll
        for (int b = 0; b < 2; ++b)
#pragma unroll
            for (int m = 0; m < 4; ++m)
#pragma unroll
                for (int n = 0; n < 2; ++n) acc[a][b][m][n] = (f32x4){0.f, 0.f, 0.f, 0.f};
    bf16x8 At[4][2], B0[2][2], B1[2][2];
    const char* cA = (const char*)g.A + (size_t)cur.pm * tstep + (size_t)cur.k0 * 2; const char* cB = (const char*)g.Bt + (size_t)cur.pn * tstep + (size_t)cur.k0 * 2;
    S.a_ready(cur);
    if constexpr (SP2) {
        PG8_STAGE(PG8_SB(0, 0), cB, voffB); PG8_STAGE(PG8_SB(0, 1), cB + hstep, voffB); PG8_STAGE(PG8_SA(0, 0), cA, voffA); PG8_STAGE(PG8_SA(0, 1), cA + hstep, voffA);
        if (wr == 1) PG8_BAR;
        PG8_WAIT_V(2); PG8_BAR;
        PG8_STAGE(PG8_SB(1, 0), cB + kstep, voffB); PG8_STAGE(PG8_SA(1, 0), cA + kstep, voffA); PG8_STAGE(PG8_SB(1, 1), cB + hstep + kstep, voffB);
        PG8_WAIT_V(6); PG8_BAR;
    } else {
        PG8_STAGE(PG8_SB(0, 0), cB, voffB); PG8_STAGE(PG8_SA(0, 0), cA, voffA); PG8_STAGE(PG8_SB(0, 1), cB + hstep, voffB); PG8_STAGE(PG8_SA(0, 1), cA + hstep, voffA);
        if (wr == 1) PG8_BAR;
        PG8_WAIT_V(4); PG8_BAR;
        PG8_STAGE(PG8_SB(1, 0), cB + kstep, voffB); PG8_STAGE(PG8_SA(1, 0), cA + kstep, voffA); PG8_STAGE(PG8_SB(1, 1), cB + hstep + kstep, voffB);
        PG8_WAIT_V(6); PG8_BAR;
    }
    for (;;) {
        const bool has_next = S.next(ui + 1, nxt);
        const char* nA = has_next ? (const char*)g.A + (size_t)nxt.pm * tstep + (size_t)nxt.k0 * 2 : cA; const char* nB = has_next ? (const char*)g.Bt + (size_t)nxt.pn * tstep + (size_t)nxt.k0 * 2 : cB;
        const int nt = cur.nt ? cur.nt : K / BK;
        for (int t = 0; t < nt; t += 2) {
            const bool last = (t == nt - 2);
            const char* a1 = cA + (size_t)(t + 1) * kstep;
            const char* a2 = last ? nA : cA + (size_t)(t + 2) * kstep; const char* b2 = last ? nB : cB + (size_t)(t + 2) * kstep;
            const char* a3 = a2 + kstep; const char* b3 = b2 + kstep;
            if (last && has_next) S.a_ready(nxt);
            if constexpr (SP2) {
            PG8_LDB(B0, 0, 0); PG8_LDB(B1, 0, 1); PG8_SCHED; PG8_LDA(At, 0, 0); PG8_STAGE(PG8_SA(1, 1), a1 + hstep, voffA);
            PG8_WAIT_V(8); PG8_WAIT_L(0); PG8_BAR; PG8_MMA(0, 0, At, B0); PG8_MMA(0, 1, At, B1); PG8_BAR; PG8_SCHED;
            PG8_LDA(At, 0, 1); PG8_STAGE(PG8_SB(0, 0), b2, voffB); PG8_STAGE(PG8_SB(0, 1), b2 + hstep, voffB); PG8_STAGE(PG8_SA(0, 0), a2, voffA);
            PG8_WAIT_V(8); PG8_WAIT_L(0); PG8_BAR; PG8_MMA(1, 0, At, B0); PG8_MMA(1, 1, At, B1); PG8_BAR; PG8_SCHED;
            PG8_LDB(B0, 1, 0); PG8_LDB(B1, 1, 1); PG8_SCHED; PG8_LDA(At, 1, 0); PG8_STAGE(PG8_SA(0, 1), a2 + hstep, voffA);
            PG8_WAIT_V(8); PG8_WAIT_L(0); PG8_BAR; PG8_MMA(0, 0, At, B0); PG8_MMA(0, 1, At, B1); PG8_BAR; PG8_SCHED;
            PG8_LDA(At, 1, 1); PG8_STAGE(PG8_SB(1, 0), b3, voffB); PG8_STAGE(PG8_SB(1, 1), b3 + hstep, voffB); PG8_STAGE(PG8_SA(1, 0), a3, voffA);
            PG8_WAIT_V(8); PG8_WAIT_L(0); PG8_BAR; PG8_MMA(1, 0, At, B0); PG8_MMA(1, 1, At, B1); PG8_BAR; PG8_SCHED;
            } else {
            PG8_LDB(B0, 0, 0); PG8_SCHED; PG8_LDA(At, 0, 0); PG8_STAGE(PG8_SA(1, 1), a1 + hstep, voffA);
            PG8_WAIT_L(8); PG8_BAR; PG8_WAIT_L(0); PG8_MMA(0, 0, At, B0); PG8_BAR; PG8_SCHED;
            PG8_LDB(B1, 0, 1); PG8_STAGE(PG8_SB(0, 0), b2, voffB);
            PG8_BAR; PG8_WAIT_L(0); PG8_MMA(0, 1, At, B1); PG8_BAR;
            PG8_LDA(At, 0, 1); PG8_STAGE(PG8_SA(0, 0), a2, voffA);
            PG8_BAR; PG8_WAIT_L(0); PG8_MMA(1, 0, At, B0); PG8_BAR; PG8_SCHED;
            PG8_STAGE(PG8_SB(0, 1), b2 + hstep, voffB);
            PG8_WAIT_V(6); PG8_BAR; PG8_MMA(1, 1, At, B1); PG8_BAR;
            PG8_LDB(B0, 1, 0); PG8_SCHED; PG8_LDA(At, 1, 0); PG8_STAGE(PG8_SA(0, 1), a2 + hstep, voffA);
            PG8_WAIT_L(8); PG8_BAR; PG8_WAIT_L(0); PG8_MMA(0, 0, At, B0); PG8_BAR; PG8_SCHED;
            PG8_LDB(B1, 1, 1); PG8_STAGE(PG8_SB(1, 0), b3, voffB);
            PG8_BAR; PG8_WAIT_L(0); PG8_MMA(0, 1, At, B1); PG8_BAR;
            PG8_LDA(At, 1, 1); PG8_STAGE(PG8_SA(1, 0), a3, voffA);
            PG8_BAR; PG8_WAIT_L(0); PG8_MMA(1, 0, At, B0); PG8_BAR; PG8_SCHED;
            PG8_STAGE(PG8_SB(1, 1), b3 + hstep, voffB);
            PG8_WAIT_V(6); PG8_BAR; PG8_MMA(1, 1, At, B1); PG8_BAR;
            }
        }
        if constexpr (ALIGN_EPI) { if (wr == 0) PG8_BAR; }
        if constexpr (!Epi::AFTER_DRAIN) { E(acc, cur, wr, wc, fr, fq); S.done(cur); }
        if (!has_next) break;
#pragma unroll
        for (int a = 0; a < 2; ++a)
#pragma unroll
            for (int b = 0; b < 2; ++b)
#pragma unroll
                for (int m = 0; m < 4; ++m)
#pragma unroll
                    for (int n = 0; n < 2; ++n) acc[a][b][m][n] = (f32x4){0.f, 0.f, 0.f, 0.f};
        cur = nxt; cA = nA; cB = nB; ++ui;
        if constexpr (ALIGN_EPI) { if (wr == 1) PG8_BAR; }
    }
    PG8_WAIT_V(0);
    if constexpr (!ALIGN_EPI) { if (wr == 0) PG8_BAR; }
    PG8_BAR;
    if constexpr (Epi::AFTER_DRAIN) { E.fused(acc, cur, wr, wc, fr, fq, lds, wid, lane); S.done(cur); }
#undef PG8_SA
#undef PG8_SB
#undef PG8_STAGE
#undef PG8_LDA
#undef PG8_LDB
#undef PG8_MMA
#undef PG8_WAIT_V
#undef PG8_WAIT_L
#undef PG8_BAR
#undef PG8_SCHED
}
}
#define XB_TMO      128
#define XB_XCNT(j)  (256  + 64 * (j))
#define XB_XSUB(j)  (1280 + 64 * (j))
#define XB_XGEN(j)  (2304 + 64 * (j))
#define XB_TOP      3328
#define XB_TOPGEN   3392
#define XCD_BAR_WORDS 3456
#define XB_SPIN_CAP (1u << 18)

__device__ __forceinline__ unsigned xb_ld(unsigned* p)              { return __hip_atomic_load(p, __ATOMIC_RELAXED, __HIP_MEMORY_SCOPE_AGENT); }
__device__ __forceinline__ unsigned xb_add(unsigned* p, unsigned v) { return __hip_atomic_fetch_add(p, v, __ATOMIC_RELAXED, __HIP_MEMORY_SCOPE_AGENT); }
__device__ __forceinline__ unsigned xb_xcc_id() { return (unsigned)__builtin_amdgcn_s_getreg((3 << 11) | 20) & 0xFu; }
#define XB_SPIN(cond, bar) do { unsigned _sp = 0; while (cond) { __builtin_amdgcn_s_sleep(1); \
    if ((++_sp & 255u) == 0u) { if (xb_ld(&(bar)[XB_TMO])) break; if (_sp > XB_SPIN_CAP) { atomicAdd(&(bar)[XB_TMO], 1u); break; } } } } while (0)

struct XcdBarrier {
    unsigned* bar; unsigned x;
    volatile LAS unsigned* st;
};

__device__ __forceinline__ XcdBarrier xcd_barrier_post(unsigned* bar, volatile LAS unsigned* st) {
    XcdBarrier b; b.bar = bar; b.x = xb_xcc_id(); b.st = st;
    if (threadIdx.x == 0) (void)xb_add(&bar[XB_XCNT(b.x)], 1u);
    return b;
}
__device__ __forceinline__ void xcd_barrier_complete(unsigned* bar, unsigned x, unsigned& nloc, unsigned& nx) {
    const unsigned G = gridDim.x * gridDim.y * gridDim.z;
    unsigned sum, cnt, mine, sp = 0u;
    for (;;) {
        sum = 0u; cnt = 0u; mine = 0u;
#pragma unroll
        for (unsigned j = 0; j < 16; ++j) { const unsigned c = xb_ld(&bar[XB_XCNT(j)]); sum += c; cnt += (c > 0u) ? 1u : 0u; mine = (j == x) ? c : mine; }
        if (sum == G) break;
        __builtin_amdgcn_s_sleep(1);
        if ((++sp & 255u) == 0u) { if (xb_ld(&bar[XB_TMO])) break; if (sp > XB_SPIN_CAP) { atomicAdd(&bar[XB_TMO], 1u); break; } }
    }
    nloc = mine > 0u ? mine : 1u; nx = cnt > 0u ? cnt : 1u;
}

__device__ __forceinline__ void xcd_barrier(const XcdBarrier& b) {
    asm volatile("s_waitcnt vmcnt(0)" ::: "memory");
    __syncthreads();
    if (threadIdx.x == 0) {
        unsigned* bar = b.bar;
        __builtin_amdgcn_s_waitcnt(0);
        unsigned nloc = b.st[0], nx = b.st[1];
        if (nloc == 0u) { xcd_barrier_complete(bar, b.x, nloc, nx); b.st[0] = nloc; b.st[1] = nx; }
        const unsigned old = xb_add(&bar[XB_XSUB(b.x)], 1u);
        const unsigned gen = old / nloc;
        if (old + 1u == (gen + 1u) * nloc) {
            __builtin_amdgcn_fence(__ATOMIC_RELEASE, "agent");
            asm volatile("s_waitcnt vmcnt(0)" ::: "memory");
            const unsigned og = xb_add(&bar[XB_TOP], 1u);
            const unsigned tg = og / nx;
            if (og + 1u == (tg + 1u) * nx) xb_add(&bar[XB_TOPGEN], 1u);
            else XB_SPIN(xb_ld(&bar[XB_TOPGEN]) == tg, bar);
            __builtin_amdgcn_fence(__ATOMIC_ACQUIRE, "agent");
            xb_add(&bar[XB_XGEN(b.x)], 1u);
            asm volatile("s_waitcnt vmcnt(0)" ::: "memory");
        } else {
            XB_SPIN(xb_ld(&bar[XB_XGEN(b.x)]) == gen, bar);
            __builtin_amdgcn_fence(__ATOMIC_ACQUIRE, "agent");
            asm volatile("s_waitcnt vmcnt(0)" ::: "memory");
        }
    }
    __syncthreads();
}


typedef __bf16 bf16x2_t __attribute__((ext_vector_type(2)));
__device__ __forceinline__ unsigned cvtpk(float lo, float hi) { f32x2 v = {lo, hi}; bf16x2_t b = __builtin_convertvector(v, bf16x2_t); return __builtin_bit_cast(unsigned, b); }
__device__ __forceinline__ float wave_sum(float v) {
#pragma unroll
    for (int o = 1; o < 64; o <<= 1) v += __shfl_xor(v, o);
    return v;
}
__device__ __forceinline__ float silu_f(float x) { return x / (1.f + __expf(-x)); }
__device__ __forceinline__ float logsigmoid_f(float z) { return fminf(z, 0.f) - __logf(1.f + __expf(-fabsf(z))); }
__device__ __forceinline__ int cond_of_row(int r) { return r < T_P ? 0 : 1 + ((r - T_P) >> 10); }
__device__ __forceinline__ int clampi(int v, int lo, int hi) { return v < lo ? lo : (v > hi ? hi : v); }

#ifndef ADA_DEFER
#define ADA_DEFER 1
#endif
#ifndef EPI_NT
#define EPI_NT 0
#endif
__device__ __forceinline__ void st16(void* p, u32x4 w) {
    if (EPI_NT == 2) asm volatile("global_store_dwordx4 %0, %1, off sc1\n\ts_nop 2" :: "v"(p), "v"(w) : "memory");
    else if (EPI_NT == 1) __builtin_nontemporal_store(w, (u32x4*)p); else *(u32x4*)p = w; }
struct Args { const float* in[21]; float* out; unsigned char* ws; int ph_lo, ph_hi; };
enum { IN_XP = 0, IN_XS, IN_CK, IN_CV, IN_SG, IN_C, IN_CCTX, IN_WADA, IN_BADA, IN_NORMG, IN_WQKV, IN_WONA, IN_RPB, IN_WQKVG, IN_WA1, IN_WA2, IN_BA, IN_GHEAD, IN_WOGLA, IN_W1, IN_W2 };
constexpr int PH_PRO = 0, PH_R0 = 1, PH_L0 = 2, PH_PER_LAYER = 8, NPH = PH_L0 + NL * PH_PER_LAYER;
enum { LP_MIX = 0, LP_CORE, LP_GATE, LP_WO, LP_ROWMID, LP_W1, LP_W2, LP_ROWEND };

struct E8NaQK {
    bf16* QK; float* newk; int li;
    __device__ __forceinline__ void store8(int row, int col, const float (&v)[8]) const {
        u32x4 w; w.x = cvtpk(v[0], v[1]); w.y = cvtpk(v[2], v[3]); w.z = cvtpk(v[4], v[5]); w.w = cvtpk(v[6], v[7]);
        { const int kpart = col >= 2048, c = col - 2048 * kpart, h = c >> 7, d = c & 127;
          st16(QK + (size_t)kpart * T * 2048 + ((size_t)h * T + row) * 128 + d, w); }
        if (col >= 2048 && row < T_P) {
            const int b = row >> 8, s = row & 255, c = col - 2048, h = c >> 7, d = c & 127;
            float* p = newk + ((((size_t)b * 2 + li) * 16 + h) * 256 + s) * 128 + d;
            *(f32x4*)p = (f32x4){v[0], v[1], v[2], v[3]}; *(f32x4*)(p + 4) = (f32x4){v[4], v[5], v[6], v[7]};
        }
    }
};
struct E8VT {
    bf16* VT; float* newv; int li;
    __device__ __forceinline__ void store8(int row, int col, const float (&v)[8]) const {
        u32x4 w; w.x = cvtpk(v[0], v[1]); w.y = cvtpk(v[2], v[3]); w.z = cvtpk(v[4], v[5]); w.w = cvtpk(v[6], v[7]);
        st16(VT + (size_t)row * VTP + col, w);
        if (newv && col < T_P) {
            const int b = col >> 8, s = col & 255, h = row >> 7, d = row & 127;
            float* p = newv + ((((size_t)b * 2 + li) * 16 + h) * 256 + s) * 128 + d;
#pragma unroll
            for (int e = 0; e < 8; ++e) p[(size_t)e * 128] = v[e];
        }
    }
};
struct E8GlaQKG {
    bf16* QK; float* TLR;
    __device__ __forceinline__ void store8(int row, int col, const float (&v)[8]) const {
        if (col < 4096) {
            u32x4 w; w.x = cvtpk(v[0], v[1]); w.y = cvtpk(v[2], v[3]); w.z = cvtpk(v[4], v[5]); w.w = cvtpk(v[6], v[7]);
            st16(QK + (size_t)row * 4096 + col, w);
        } else if (col < 4128) {
            float* p = TLR + (size_t)row * 32 + (col - 4096);
            *(f32x4*)p = (f32x4){v[0], v[1], v[2], v[3]}; *(f32x4*)(p + 4) = (f32x4){v[4], v[5], v[6], v[7]};
        }
    }
};
struct E8F32 {
    float* Y; int ldc;
    __device__ __forceinline__ void store8(int row, int col, const float (&v)[8]) const {
        float* p = Y + (size_t)row * ldc + col;
        *(f32x4*)p = (f32x4){v[0], v[1], v[2], v[3]}; *(f32x4*)(p + 4) = (f32x4){v[4], v[5], v[6], v[7]};
    }
};
struct E8Bf16 {
    bf16* O; int ldc;
    __device__ __forceinline__ void store8(int row, int col, const float (&v)[8]) const {
        u32x4 w; w.x = cvtpk(v[0], v[1]); w.y = cvtpk(v[2], v[3]); w.z = cvtpk(v[4], v[5]); w.w = cvtpk(v[6], v[7]);
        st16(O + (size_t)row * ldc + col, w);
    }
};
struct E8Relu2 {
    bf16* O; int ldc;
    __device__ __forceinline__ void store8(int row, int col, const float (&v)[8]) const {
        float r[8];
#pragma unroll
        for (int e = 0; e < 8; ++e) { const float t = fmaxf(v[e], 0.f); r[e] = t * t; }
        u32x4 w; w.x = cvtpk(r[0], r[1]); w.y = cvtpk(r[2], r[3]); w.z = cvtpk(r[4], r[5]); w.w = cvtpk(r[6], r[7]);
        st16(O + (size_t)row * ldc + col, w);
    }
};
template <class E8> struct EpiWrap {
    static constexpr bool PERM = true, AFTER_DRAIN = false;
    E8 e;
    __device__ __forceinline__ void operator()(const pg8::f32x4 (&acc)[2][2][4][2], const pg8::Unit& u, int wr, int wc, int fr, int fq) const {
        const int row0 = u.pm * 256 + wr * 64 + fr, col0 = u.pn * 256 + wc * 32 + 8 * fq;
#pragma unroll
        for (int ai = 0; ai < 2; ++ai)
#pragma unroll
            for (int m = 0; m < 4; ++m)
#pragma unroll
                for (int bj = 0; bj < 2; ++bj) {
                    const pg8::f32x4 a = acc[ai][bj][m][0], b = acc[ai][bj][m][1];
                    const float v[8] = {a[0], a[1], a[2], a[3], b[0], b[1], b[2], b[3]};
                    e.store8(row0 + ai * 128 + m * 16, col0 + bj * 128, v);
                }
    }
};

constexpr int W2_NT_MAIN = 100;
struct SplitKOrder {
    int c;
    __device__ static void map(int L, pg8::Unit& u) {
        const int nM = 24, nN = 8, nwg = 192;
        int wgid = L; { const int q = nwg / 8, xcd = wgid % 8, off = wgid / 8; wgid = xcd * q + off; }
        const int nig = 8 * nN, gid = wgid / nig, fm = gid * 8, gsz = (nM - fm) < 8 ? (nM - fm) : 8;
        u.pm = fm + ((wgid % nig) % gsz); u.pn = (wgid % nig) / gsz;
    }
    __device__ bool next(int i, pg8::Unit& u) const {
        if (c < 192) { if (i > 0) return false; map(c, u); u.k0 = 0; u.nt = W2_NT_MAIN; u.part = 0; return true; }
        if (i >= 3) return false;
        map(3 * (c - 192) + i, u); u.k0 = W2_NT_MAIN * 64; u.nt = 128 - W2_NT_MAIN; u.part = 1; return true;
    }
    __device__ __forceinline__ void a_ready(const pg8::Unit&) const {}
    __device__ __forceinline__ void done(const pg8::Unit&) const {}
};
struct EpiF32Part {
    static constexpr bool PERM = true, AFTER_DRAIN = false;
    float* Y0; float* Y1;
    __device__ __forceinline__ void operator()(const pg8::f32x4 (&acc)[2][2][4][2], const pg8::Unit& u, int wr, int wc, int fr, int fq) const {
        const int row0 = u.pm * 256 + wr * 64 + fr, col0 = u.pn * 256 + wc * 32 + 8 * fq;
        float* Y = u.part ? Y1 : Y0;
#pragma unroll
        for (int ai = 0; ai < 2; ++ai)
#pragma unroll
            for (int m = 0; m < 4; ++m)
#pragma unroll
                for (int bj = 0; bj < 2; ++bj) {
                    float* p = Y + (size_t)(row0 + ai * 128 + m * 16) * D + col0 + bj * 128;
                    *(f32x4*)p = acc[ai][bj][m][0]; *(f32x4*)(p + 4) = acc[ai][bj][m][1];
                }
    }
};

__device__ __forceinline__ void tr_item(const float* src, size_t ldsrc, bf16* dst, size_t lddst, LAS float* scr, int lane) {
    const float* sp_ = src + (size_t)(lane >> 5) * ldsrc + (lane & 31); LAS float* dp_ = scr + (lane >> 5) * 33 + (lane & 31);
#pragma unroll 1
    for (int h = 0; h < 2; ++h, sp_ += 32 * ldsrc, dp_ += 32 * 33) {
        float tv[16];
#pragma unroll
        for (int i = 0; i < 16; ++i) tv[i] = __builtin_nontemporal_load(sp_ + (size_t)(2 * i) * ldsrc);
#pragma unroll
        for (int i = 0; i < 16; ++i) dp_[2 * i * 33] = tv[i];
    }
    LDS_WAIT(); asm volatile("" ::: "memory");
    const int c = lane & 7;
#pragma unroll
    for (int j = 0; j < 4; ++j) { const int n = (lane >> 3) + 8 * j; const LAS float* s = scr + (8 * c) * 33 + n;
        u32x4 o; o.x = cvtpk(s[0 * 33], s[1 * 33]); o.y = cvtpk(s[2 * 33], s[3 * 33]); o.z = cvtpk(s[4 * 33], s[5 * 33]); o.w = cvtpk(s[6 * 33], s[7 * 33]);
        *(u32x4*)(dst + (size_t)n * lddst + 8 * c) = o; }
    LDS_WAIT(); asm volatile("" ::: "memory");
}
constexpr int PRO_SCR_BYTES = 8448, PRO_SILU_OFF = 8 * PRO_SCR_BYTES  , PRO_PART_OFF = PRO_SILU_OFF + 3 * 2048 * 4  ;
constexpr int LY_ADA = 192, LY_TR = 3072, LY_A1 = 32, LY_ITEMS = LY_ADA + LY_TR + LY_A1;

__device__ __forceinline__ void silu_table(const Args& a, LAS unsigned char* lds, int tid) {
    LAS float* sil = (LAS float*)(lds + PRO_SILU_OFF);
    for (int e = tid; e < 3 * 2048; e += 512) { const int c = e >> 11, k = e & 2047; const float x = c == 0 ? a.in[IN_CCTX][k] : a.in[IN_C][(c - 1) * 2048 + k]; sil[e] = silu_f(x); }
    __syncthreads();
}
__device__ __forceinline__ void ada_layer(const Args& a, LAS unsigned char* lds, int l, int b0, int nb, int tid) {
    const int lane = tid & 63, wave = __builtin_amdgcn_readfirstlane(tid >> 6);
    LAS float* sil = (LAS float*)(lds + PRO_SILU_OFF);
    LAS float* part = (LAS float*)(lds + PRO_PART_OFF);
    for (int cg = b0; cg < LY_ADA; cg += nb) {
        const float* W = a.in[IN_WADA] + (size_t)l * 2048 * 12288 + cg * 64 + lane;
        float a0 = 0.f, a1 = 0.f, a2 = 0.f;
        const int k0 = wave * 256;
#pragma unroll 1
        for (int kc = 0; kc < 256; kc += 16) {
            float wv[16];
#pragma unroll
            for (int k = 0; k < 16; ++k) wv[k] = __builtin_nontemporal_load(W + (size_t)(k0 + kc + k) * 12288);
#pragma unroll
            for (int k = 0; k < 16; ++k) { a0 += sil[k0 + kc + k] * wv[k]; a1 += sil[2048 + k0 + kc + k] * wv[k]; a2 += sil[4096 + k0 + kc + k] * wv[k]; }
        }
        part[(wave * 3 + 0) * 64 + lane] = a0; part[(wave * 3 + 1) * 64 + lane] = a1; part[(wave * 3 + 2) * 64 + lane] = a2;
        __syncthreads();
        if (tid < 192) { const int c = tid >> 6, col = tid & 63; float sacc = 0.f;
#pragma unroll
            for (int w = 0; w < 8; ++w) sacc += part[(w * 3 + c) * 64 + col];
            ((float*)(a.ws + WS_MOD))[((size_t)l * 3 + c) * 12288 + cg * 64 + col] = sacc + a.in[IN_BADA][l * 12288 + cg * 64 + col]; }
        __syncthreads();
    }
}
__device__ __forceinline__ void convert_weights(const Args& a, LAS unsigned char* lds, int l, int it_lo, int it_hi, int b0, int nb, int tid) {
    const int lane = tid & 63, wave = __builtin_amdgcn_readfirstlane(tid >> 6);
    LAS float* scr = (LAS float*)(lds + wave * PRO_SCR_BYTES);
    unsigned char* ws = a.ws;
    const int i = l >> 1; const bool gla = l & 1;
    for (int it = it_lo + b0; it < it_hi; it += nb) {
        int r = it;
        if (r < LY_TR) {
            if (r < 768) {
                const int kb = r / 24, nb2 = r % 24;
                const float* src = (gla ? a.in[IN_WQKVG] : a.in[IN_WQKV]) + (size_t)i * 2048 * 6144;
                int db = nb2; if (gla) { if (nb2 >= 16) db = 8 + (nb2 - 16); else if (nb2 >= 8) db = 17 + (nb2 - 8); }
                bf16* dst = (bf16*)(ws + WS_WMIX) + (size_t)l * NMIX * D;
                tr_item(src + (size_t)(kb * 64) * 6144 + nb2 * 256 + wave * 32, 6144, dst + (size_t)(db * 256 + wave * 32) * D + kb * 64, D, scr, lane);
            } else if (r < 1024) {
                r -= 768; const int kb = r / 8, nb2 = r % 8;
                const float* src = (gla ? a.in[IN_WOGLA] : a.in[IN_WONA]) + (size_t)i * 2048 * 2048;
                bf16* dst = (bf16*)(ws + WS_WO) + (size_t)l * D * D;
                tr_item(src + (size_t)(kb * 64) * 2048 + nb2 * 256 + wave * 32, 2048, dst + (size_t)(nb2 * 256 + wave * 32) * D + kb * 64, D, scr, lane);
            } else if (r < 2048) {
                r -= 1024; const int kb = r / 32, nb2 = r % 32;
                const float* src = a.in[IN_W1] + (size_t)l * 2048 * 8192;
                bf16* dst = (bf16*)(ws + WS_W1) + (size_t)l * FF * D;
                tr_item(src + (size_t)(kb * 64) * 8192 + nb2 * 256 + wave * 32, 8192, dst + (size_t)(nb2 * 256 + wave * 32) * D + kb * 64, D, scr, lane);
            } else {
                r -= 2048; const int kb = r / 8, nb2 = r % 8;
                const float* src = a.in[IN_W2] + (size_t)l * 8192 * 2048;
                bf16* dst = (bf16*)(ws + WS_W2) + (size_t)l * D * FF;
                tr_item(src + (size_t)(kb * 64) * 2048 + nb2 * 256 + wave * 32, 2048, dst + (size_t)(nb2 * 256 + wave * 32) * FF + kb * 64, FF, scr, lane);
            }
            continue;
        }
        r -= LY_TR;
        if (gla) {
            const int p = r;
            bf16* dst = (bf16*)(ws + WS_WMIX) + (size_t)l * NMIX * D + (size_t)4096 * D;
            for (int q = 0; q < 32; ++q) { const int e = tid + 512 * q, rr = e >> 11, k = e & 2047, prow = 8 * p + rr;
                float val = 0.f; if (prow < 32) val = a.in[IN_WA1][(((size_t)i * 2 + (prow >> 4)) * 2048 + k) * 16 + (prow & 15)];
                dst[(size_t)prow * D + k] = (bf16)f2bf(val); }
        }
    }
}
constexpr int CV_WITEMS = LY_TR + LY_A1;
#ifndef CVMIX
#define CVMIX 1100
#define CVWO 1500
#define CVW2 3104
#endif
constexpr int CV_MIX_END = CVMIX, CV_WO_END = CVWO, CV_W2_END = CVW2;
constexpr int PRO_CK = 512, PRO_CV = 128;
__device__ __forceinline__ void prologue_phase(const Args& a, LAS unsigned char* lds, int bid, int G, int tid) {
    const int lane = tid & 63, wave = __builtin_amdgcn_readfirstlane(tid >> 6);
    LAS float* scr = (LAS float*)(lds + wave * PRO_SCR_BYTES);
    unsigned char* ws = a.ws;
    silu_table(a, lds, tid);
    const bool defer = (G == 256);
    for (int l = 0; l < ((ADA_DEFER && defer) ? 1 : NL); ++l) ada_layer(a, lds, l, (bid + 64 * l) % G, G, tid);
    convert_weights(a, lds, 0, 0, CV_WITEMS, bid, G, tid);
    for (int l = 1; l < NL; ++l) convert_weights(a, lds, l, defer ? CV_W2_END : 0, CV_WITEMS, (bid + 37 * l) % G, G, tid);
    for (int r = bid; r < PRO_CK + PRO_CV; r += G) {
        if (r < PRO_CK) {
            const size_t e0 = ((size_t)r * 512 + tid) * 8;
            const f32x4 x0 = *(const f32x4*)(a.in[IN_CK] + e0), x1 = *(const f32x4*)(a.in[IN_CK] + e0 + 4);
            u32x4 w; w.x = cvtpk(x0[0], x0[1]); w.y = cvtpk(x0[2], x0[3]); w.z = cvtpk(x1[0], x1[1]); w.w = cvtpk(x1[2], x1[3]);
            *(u32x4*)((bf16*)(ws + WS_CK) + e0) = w;
        } else {
            const int rr = r - PRO_CK, mat = rr >> 1, kh = rr & 1, kb = kh * 2 + (wave >> 2), nb2 = wave & 3;
            tr_item(a.in[IN_CV] + (size_t)mat * 256 * 128 + (size_t)(kb * 64) * 128 + nb2 * 32, 128, (bf16*)(ws + WS_CVT) + (size_t)mat * 128 * 256 + (size_t)(nb2 * 32) * 256 + kb * 64, 256, scr, lane);
        }
    }
}

template <bool FIRST, bool UPD, bool EMIT, bool ADD2 = false>
__device__ __forceinline__ void row_phase(const Args& a, int gw, int ngw, int lane, const float* ga, const float* modU, int jgate, const float* gb, const float* modE, int jshift, int jscale) {
    float* X = a.out + OUT_X; const float* Y = (const float*)(a.ws + WS_Y); bf16* H = (bf16*)(a.ws + WS_H);
    const int rpw = (T + ngw - 1) / ngw, r0 = gw * rpw, r1 = (r0 + rpw < T) ? r0 + rpw : T;
    f32x4 c1[8], c2[8], c3[8];
    int cur = -1;
    for (int r = r0; r < r1; ++r) {
        const int cond = cond_of_row(r);
        if (cond != cur) {
            cur = cond;
            if (UPD) { const float* gate = modU + ((size_t)cond * 6 + jgate) * D;
#pragma unroll
                for (int j = 0; j < 8; ++j) c1[j] = *(const f32x4*)(gate + 256 * j + 4 * lane) * *(const f32x4*)(ga + 256 * j + 4 * lane); }
            if (EMIT) { const float* sh = modE + ((size_t)cond * 6 + jshift) * D; const float* sc = modE + ((size_t)cond * 6 + jscale) * D;
#pragma unroll
                for (int j = 0; j < 8; ++j) { c2[j] = *(const f32x4*)(gb + 256 * j + 4 * lane) * (*(const f32x4*)(sc + 256 * j + 4 * lane) + 1.f); c3[j] = *(const f32x4*)(sh + 256 * j + 4 * lane); } }
        }
        const float* xin = FIRST ? (r < T_P ? a.in[IN_XP] + (size_t)r * D : a.in[IN_XS] + (size_t)(r - T_P) * D) : X + (size_t)r * D;
        f32x4 x[8];
#pragma unroll
        for (int j = 0; j < 8; ++j) x[j] = *(const f32x4*)(xin + 256 * j + 4 * lane);
        if (UPD) {
            f32x4 y[8]; float ss = 0.f;
#pragma unroll
            for (int j = 0; j < 8; ++j) {
                if (Y_BF16) { const u32x2 yw = *(const u32x2*)((const bf16*)Y + (size_t)r * D + 256 * j + 4 * lane); y[j] = (f32x4){bflo(yw.x), bfhi(yw.x), bflo(yw.y), bfhi(yw.y)}; }
                else { y[j] = *(const f32x4*)(Y + (size_t)r * D + 256 * j + 4 * lane); if (ADD2) y[j] = y[j] + *(const f32x4*)(Y + (size_t)T * D + (size_t)r * D + 256 * j + 4 * lane); }
                ss += (y[j][0] * y[j][0] + y[j][1] * y[j][1]) + (y[j][2] * y[j][2] + y[j][3] * y[j][3]); }
            const float rinv = rsqrtf(wave_sum(ss) * (1.f / D) + EPS);
#pragma unroll
            for (int j = 0; j < 8; ++j) x[j] = x[j] + c1[j] * (y[j] * rinv);
        }
        if (FIRST || UPD) {
#pragma unroll
            for (int j = 0; j < 8; ++j) *(f32x4*)(X + (size_t)r * D + 256 * j + 4 * lane) = x[j];
        }
        if (EMIT) {
            float ss = 0.f;
#pragma unroll
            for (int j = 0; j < 8; ++j) ss += (x[j][0] * x[j][0] + x[j][1] * x[j][1]) + (x[j][2] * x[j][2] + x[j][3] * x[j][3]);
            const float rinv = rsqrtf(wave_sum(ss) * (1.f / D) + EPS);
#pragma unroll
            for (int j = 0; j < 8; ++j) { const f32x4 h = (x[j] * rinv) * c2[j] + c3[j];
                u32x2 w; w.x = cvtpk(h[0], h[1]); w.y = cvtpk(h[2], h[3]);
                *(u32x2*)(H + (size_t)r * D + 256 * j + 4 * lane) = w; }
        }
    }
}

__device__ __forceinline__ void gla_gate_phase(const Args& a, int gw, int ngw, int lane, int li) {
    const float* OG = (const float*)(a.ws + WS_OG); const bf16* QK = (const bf16*)(a.ws + WS_QK); bf16* AO = (bf16*)(a.ws + WS_AO);
    const float* gh = a.in[IN_GHEAD] + (size_t)li * 512;
    for (int r = gw; r < T; r += ngw) {
        f32x4 o[8];
#pragma unroll
        for (int j = 0; j < 8; ++j) {
            if (OG_BF16) { const bf16* og = (const bf16*)OG; const u32x2 p0 = *(const u32x2*)(og + (size_t)r * D + 256 * j + 4 * lane), p1 = *(const u32x2*)(og + (size_t)T * D + (size_t)r * D + 256 * j + 4 * lane);
                o[j] = (f32x4){bflo(p0.x) + bflo(p1.x), bfhi(p0.x) + bfhi(p1.x), bflo(p0.y) + bflo(p1.y), bfhi(p0.y) + bfhi(p1.y)}; }
            else o[j] = *(const f32x4*)(OG + (size_t)r * D + 256 * j + 4 * lane) + *(const f32x4*)(OG + (size_t)T * D + (size_t)r * D + 256 * j + 4 * lane);
        }
#pragma unroll
        for (int hh = 0; hh < 4; ++hh) {
            float ss = 0.f;
#pragma unroll
            for (int jj = 0; jj < 2; ++jj) { const f32x4 v = o[2 * hh + jj]; ss += (v[0] * v[0] + v[1] * v[1]) + (v[2] * v[2] + v[3] * v[3]); }
            const float rinv = rsqrtf(wave_sum(ss) * (1.f / 512.f) + EPS);
#pragma unroll
            for (int jj = 0; jj < 2; ++jj) { const int j = 2 * hh + jj, c = 256 * j + 4 * lane;
                const f32x4 g = *(const f32x4*)(gh + (c & 511));
                const u32x2 gw2 = *(const u32x2*)(QK + (size_t)r * 4096 + 2048 + c);
                const float g0 = bflo(gw2.x), g1 = bfhi(gw2.x), g2 = bflo(gw2.y), g3 = bfhi(gw2.y);
                const f32x4 v = o[j] * rinv * g;
                u32x2 w; w.x = cvtpk(v[0] * silu_f(g0), v[1] * silu_f(g1)); w.y = cvtpk(v[2] * silu_f(g2), v[3] * silu_f(g3));
                *(u32x2*)(AO + (size_t)r * D + c) = w; }
        }
    }
}

template <class E8> __global__ __launch_bounds__(256) void ref_gemm(const bf16* A, const bf16* Bt, int M, int N, int K, E8 E) {
    __shared__ __attribute__((aligned(16))) float As[32][68]; __shared__ __attribute__((aligned(16))) float Bs[32][68];
    const int t = threadIdx.x, m0 = blockIdx.y * 64, n0 = blockIdx.x * 64, lr = t >> 2, lk = (t & 3) * 8, ty = t >> 3, tx = t & 7;
    float acc[2][8];
#pragma unroll
    for (int i = 0; i < 2; ++i)
#pragma unroll
        for (int j = 0; j < 8; ++j) acc[i][j] = 0.f;
    for (int k0 = 0; k0 < K; k0 += 32) {
        const u32x4 av = *(const u32x4*)(A + (size_t)(m0 + lr) * K + k0 + lk), bv = *(const u32x4*)(Bt + (size_t)(n0 + lr) * K + k0 + lk);
        __syncthreads();
        As[lk + 0][lr] = bflo(av.x); As[lk + 1][lr] = bfhi(av.x); As[lk + 2][lr] = bflo(av.y); As[lk + 3][lr] = bfhi(av.y); As[lk + 4][lr] = bflo(av.z); As[lk + 5][lr] = bfhi(av.z); As[lk + 6][lr] = bflo(av.w); As[lk + 7][lr] = bfhi(av.w);
        Bs[lk + 0][lr] = bflo(bv.x); Bs[lk + 1][lr] = bfhi(bv.x); Bs[lk + 2][lr] = bflo(bv.y); Bs[lk + 3][lr] = bfhi(bv.y); Bs[lk + 4][lr] = bflo(bv.z); Bs[lk + 5][lr] = bfhi(bv.z); Bs[lk + 6][lr] = bflo(bv.w); Bs[lk + 7][lr] = bfhi(bv.w);
        __syncthreads();
#pragma unroll 8
        for (int kk = 0; kk < 32; ++kk) {
            const float a0 = As[kk][2 * ty], a1 = As[kk][2 * ty + 1];
            const f32x4 b0 = *(const f32x4*)&Bs[kk][8 * tx], b1 = *(const f32x4*)&Bs[kk][8 * tx + 4];
#pragma unroll
            for (int j = 0; j < 4; ++j) { acc[0][j] += a0 * b0[j]; acc[0][4 + j] += a0 * b1[j]; acc[1][j] += a1 * b0[j]; acc[1][4 + j] += a1 * b1[j]; }
        }
    }
    E.store8(m0 + 2 * ty, n0 + 8 * tx, acc[0]); E.store8(m0 + 2 * ty + 1, n0 + 8 * tx, acc[1]);
}

__global__ __launch_bounds__(128) void ref_attn(Args a, int li) {
    __shared__ float qs[128]; __shared__ float sc[768]; __shared__ float red[4];
    const bf16* QK = (const bf16*)(a.ws + WS_QK); const bf16* VT = (const bf16*)(a.ws + WS_VT); const bf16* CK = (const bf16*)(a.ws + WS_CK); const bf16* CVT = (const bf16*)(a.ws + WS_CVT);
    bf16* AO = (bf16*)(a.ws + WS_AO);
    const int tok = blockIdx.x >> 4, h = blockIdx.x & 15, tid = threadIdx.x;
    qs[tid] = bf2f(QK[((size_t)h * T + tok) * 128 + tid]);
    __syncthreads();
    const bool lat = tok >= T_P; const int nkeys = lat ? 768 : 256;
    const int bs = lat ? (tok - T_P) >> 10 : 0, tt = (tok - T_P) & 1023, r = tt >> 6, cq = tt & 63, row_start = clampi(r - 4, 0, 8), col_start = clampi(cq - 8, 0, 48);
    const float scale = 0.08838834764831845f;
    float lmax = -3.0e38f;
    for (int key = tid; key < nkeys; key += 128) {
        const bf16* kp; bool valid = true; float bias = 0.f;
        if (!lat) kp = QK + (size_t)T * 2048 + ((size_t)h * T + (tok & ~255) + key) * 128;
        else if (key < 512) { const int kri = key >> 6, ck = key & 63, krow = row_start + kri;
            kp = QK + (size_t)T * 2048 + ((size_t)h * T + T_P + bs * 1024 + krow * 64 + ck) * 128;
            valid = ck >= col_start && ck < col_start + 16;
            const int dr = krow - r + 7, dc = clampi(ck - cq + 15, 0, 30);
            bias = a.in[IN_RPB][(((size_t)li * 16 + h) * 15 + dr) * 31 + dc];
        } else kp = CK + ((((size_t)bs * 2 + li) * 16 + h) * 256 + (key - 512)) * 128;
        float s = 0.f;
        for (int d = 0; d < 128; ++d) s += qs[d] * bf2f(kp[d]);
        s = valid ? s * scale + bias : -1e30f;
        sc[key] = s; lmax = fmaxf(lmax, s);
    }
    for (int o = 32; o >= 1; o >>= 1) lmax = fmaxf(lmax, __shfl_xor(lmax, o));
    if ((tid & 63) == 0) red[tid >> 6] = lmax;
    __syncthreads();
    const float mx = fmaxf(red[0], red[1]);
    float lsum = 0.f;
    for (int key = tid; key < nkeys; key += 128) { const float p = __expf(sc[key] - mx); sc[key] = p; lsum += p; }
    for (int o = 32; o >= 1; o >>= 1) lsum += __shfl_xor(lsum, o);
    if ((tid & 63) == 0) red[2 + (tid >> 6)] = lsum;
    __syncthreads();
    const float inv = 1.f / (red[2] + red[3]);
    float o = 0.f; const int d = tid;
    if (!lat) { const bf16* vp = VT + (size_t)(h * 128 + d) * VTP + (tok & ~255); for (int key = 0; key < 256; ++key) o += sc[key] * bf2f(vp[key]); }
    else {
        const bf16* vp = VT + (size_t)(h * 128 + d) * VTP + T_P + bs * 1024 + row_start * 64; for (int key = 0; key < 512; ++key) o += sc[key] * bf2f(vp[key]);
        const bf16* cp = CVT + ((((size_t)bs * 2 + li) * 16 + h) * 128 + d) * 256; for (int key = 0; key < 256; ++key) o += sc[512 + key] * bf2f(cp[key]);
    }
    AO[(size_t)tok * D + h * 128 + d] = (bf16)f2bf(o * inv);
}

__device__ __forceinline__ float rope_dim(const bf16* xp, int j, int pos_r, int pos_c) {
    const int half = j >> 7, second = (j >> 6) & 1, i = j & 63;
    const float x1 = bf2f(xp[half * 128 + i]), x2 = bf2f(xp[half * 128 + 64 + i]);
    const float freq = exp2f(-(float)i * (13.287712379549449f / 64.f));
    const float ang = (float)(half ? pos_c : pos_r) * freq;
    float rev = ang * 0.15915494309189535f; rev -= floorf(rev);
    const float sn = __builtin_amdgcn_sinf(rev), cs = __builtin_amdgcn_cosf(rev);
    return second ? (x1 * sn + x2 * cs) : (x1 * cs - x2 * sn);
}
__global__ __launch_bounds__(256) void ref_gla(Args a, int li) {
    __shared__ float red[4][8];
    const bf16* QK = (const bf16*)(a.ws + WS_QK); const bf16* VT = (const bf16*)(a.ws + WS_VT); const float* TLR = (const float*)(a.ws + WS_TLR); float* OG = (float*)(a.ws + WS_OG);
    int u = blockIdx.x; const int dvg = u & 63; u >>= 6; const int dir = u & 1; u >>= 1; const int hh = u & 3; const int seq = u >> 2;
    const int j = threadIdx.x, lane = j & 63, wv = j >> 6;
    const bool lat = seq >= 16; const int tb = lat ? T_P + (seq - 16) * 1024 : seq * 256, L = lat ? 1024 : 256, dv0 = dvg * 8;
    float S[8];
#pragma unroll
    for (int e = 0; e < 8; ++e) S[e] = lat ? a.in[IN_SG][(((((size_t)(seq - 16) * 2 + li) * 2 + dir) * 4 + hh) * 256 + j) * 512 + dv0 + e] : 0.f;
    float w2[16];
#pragma unroll
    for (int r = 0; r < 16; ++r) w2[r] = a.in[IN_WA2][(((size_t)li * 2 + dir) * 16 + r) * 1024 + hh * 256 + j];
    const float bz = a.in[IN_BA][((size_t)li * 2 + dir) * 1024 + hh * 256 + j];
    for (int p = 0; p < L; ++p) {
        const int to = dir ? L - 1 - p : p, tok = tb + to;
        float z = bz;
#pragma unroll
        for (int r = 0; r < 16; ++r) z += TLR[(size_t)tok * 32 + dir * 16 + r] * w2[r];
        const float dec = __expf(logsigmoid_f(z) * (1.f / 16.f));
        float qv, kv;
        const bf16* qp = QK + (size_t)tok * 4096 + hh * 256; const bf16* kp = qp + 1024;
        if (lat) { qv = rope_dim(qp, j, to >> 6, to & 63); kv = rope_dim(kp, j, to >> 6, to & 63); } else { qv = bf2f(qp[j]); kv = bf2f(kp[j]); }
        qv *= 0.0625f;
        float pr[8];
#pragma unroll
        for (int e = 0; e < 8; ++e) { const float v = bf2f(VT[(size_t)(hh * 512 + dv0 + e) * VTP + tok]); S[e] = dec * S[e] + kv * v; pr[e] = qv * S[e]; }
#pragma unroll
        for (int e = 0; e < 8; ++e) { float s = pr[e]; for (int o = 32; o >= 1; o >>= 1) s += __shfl_xor(s, o); pr[e] = s; }
        __syncthreads();
        if (lane == 0) {
#pragma unroll
            for (int e = 0; e < 8; ++e) red[wv][e] = pr[e]; }
        __syncthreads();
        if (j < 8) OG[(size_t)dir * T * D + (size_t)tok * D + hh * 512 + dv0 + j] = (red[0][j] + red[1][j]) + (red[2][j] + red[3][j]);
    }
    if (!lat) {
#pragma unroll
        for (int e = 0; e < 8; ++e) a.out[OUT_GLA + (((((size_t)seq * 2 + li) * 2 + dir) * 4 + hh) * 256 + j) * 512 + dv0 + e] = S[e];
    }
}

#define MFMA16(a, b, c) __builtin_amdgcn_mfma_f32_16x16x32_bf16((a), (b), (c), 0, 0, 0)
struct AttState { f32x4 o[8]; float m, l; };

struct AttFrags { bf16x8 kf[2][4]; bf16x8 vf[8]; };
constexpr int AT_KP = 136, AT_VP = 72, AT_KB = 64 * AT_KP * 2  , AT_VB = 128 * AT_VP * 2  , AT_STAGE = AT_KB + AT_VB  , AT_RP = 2 * AT_STAGE  ;
struct AttSrc { const bf16* kb; const bf16* vb; int vstride; };

__device__ __forceinline__ void attn_half(AttState& st, const bf16x8 (&qf)[4], LAS unsigned char* lds, unsigned kfo, unsigned vfo, int kg, int lat, int rprow, int ck0, int qcol, int col_start) {
    const float SC = 0.08838834764831845f * LOG2E;
    AttFrags f;
#pragma unroll
    for (int s = 0; s < 2; ++s)
#pragma unroll
        for (int c = 0; c < 4; ++c) f.kf[s][c] = *(const LAS bf16x8*)(lds + kfo + s * (4 * AT_KP * 2) + c * 64);
#pragma unroll
    for (int dt = 0; dt < 8; ++dt) f.vf[dt] = *(const LAS bf16x8*)(lds + vfo + dt * (16 * AT_VP * 2));
    f32x4 sa[2];
#pragma unroll
    for (int s = 0; s < 2; ++s) { f32x4 acc = {0.f, 0.f, 0.f, 0.f};
#pragma unroll
        for (int c = 0; c < 4; ++c) acc = MFMA16(f.kf[s][c], qf[c], acc);
        sa[s] = acc; }
    const LAS float* rp = (const LAS float*)(lds + AT_RP);
    float mx = -1e30f; float v[8];
#pragma unroll
    for (int e = 0; e < 8; ++e) { const int ck = ck0 + 8 * kg + e; const bool valid = !lat || (ck >= col_start && ck < col_start + 16);
        const float b = lat ? rp[rprow * 32 + clampi(ck - qcol + 15, 0, 30)] * LOG2E : 0.f;
        v[e] = valid ? sa[e >> 2][e & 3] * SC + b : -1e30f; mx = fmaxf(mx, v[e]); }
    mx = fmaxf(mx, __shfl_xor(mx, 16)); mx = fmaxf(mx, __shfl_xor(mx, 32));
    const float mn = fmaxf(st.m, mx), alpha = __builtin_amdgcn_exp2f(st.m - mn);
    float ps = 0.f; float p[8];
#pragma unroll
    for (int e = 0; e < 8; ++e) { const float ex = __builtin_amdgcn_exp2f(v[e] - mn); p[e] = v[e] > -1e29f ? ex : 0.f; ps += p[e]; }
    u32x4 w; w.x = cvtpk(p[0], p[1]); w.y = cvtpk(p[2], p[3]); w.z = cvtpk(p[4], p[5]); w.w = cvtpk(p[6], p[7]);
    const bf16x8 pf = __builtin_bit_cast(bf16x8, w);
    ps += __shfl_xor(ps, 16); ps += __shfl_xor(ps, 32);
    st.l = st.l * alpha + ps; st.m = mn;
#pragma unroll
    for (int dt = 0; dt < 8; ++dt) st.o[dt] = MFMA16(f.vf[dt], pf, st.o[dt] * alpha);
}

__device__ __forceinline__ void attn_full(AttState& st, const bf16x8 (&qf)[4], LAS unsigned char* lds, unsigned kfo, unsigned vfo) {
    const float SC = 0.08838834764831845f * LOG2E;
    f32x4 sa[4];
#pragma unroll
    for (int hs = 0; hs < 4; ++hs) {
        f32x4 acc = {0.f, 0.f, 0.f, 0.f};
#pragma unroll
        for (int c = 0; c < 4; ++c) { const bf16x8 kf = *(const LAS bf16x8*)(lds + kfo + (hs >> 1) * (32 * AT_KP * 2) + (hs & 1) * (4 * AT_KP * 2) + c * 64); acc = MFMA16(kf, qf[c], acc); }
        sa[hs] = acc * SC; }
    float mx = fmaxf(fmaxf(fmaxf(sa[0][0], sa[0][1]), fmaxf(sa[0][2], sa[0][3])), fmaxf(fmaxf(sa[1][0], sa[1][1]), fmaxf(sa[1][2], sa[1][3])));
    mx = fmaxf(mx, fmaxf(fmaxf(fmaxf(sa[2][0], sa[2][1]), fmaxf(sa[2][2], sa[2][3])), fmaxf(fmaxf(sa[3][0], sa[3][1]), fmaxf(sa[3][2], sa[3][3]))));
    mx = fmaxf(mx, __shfl_xor(mx, 16)); mx = fmaxf(mx, __shfl_xor(mx, 32));
    const float mn = fmaxf(st.m, mx), alpha = __builtin_amdgcn_exp2f(st.m - mn);
    float ps = 0.f; bf16x8 pf[2];
#pragma unroll
    for (int hf = 0; hf < 2; ++hf) { float p[8];
#pragma unroll
        for (int e = 0; e < 8; ++e) { p[e] = __builtin_amdgcn_exp2f(sa[2 * hf + (e >> 2)][e & 3] - mn); ps += p[e]; }
        u32x4 w; w.x = cvtpk(p[0], p[1]); w.y = cvtpk(p[2], p[3]); w.z = cvtpk(p[4], p[5]); w.w = cvtpk(p[6], p[7]);
        pf[hf] = __builtin_bit_cast(bf16x8, w); }
    ps += __shfl_xor(ps, 16); ps += __shfl_xor(ps, 32);
    st.l = st.l * alpha + ps; st.m = mn;
#pragma unroll
    for (int dt = 0; dt < 8; ++dt) { f32x4 o = st.o[dt] * alpha;
#pragma unroll
        for (int hf = 0; hf < 2; ++hf) { const bf16x8 vf = *(const LAS bf16x8*)(lds + vfo + hf * 64 + dt * (16 * AT_VP * 2)); o = MFMA16(vf, pf[hf], o); }
        st.o[dt] = o; }
}

__device__ __forceinline__ void attn_phase(const Args& a, LAS unsigned char* lds, int bid, int G, int tid, int li, int ulo = 0, int uhi = 768) {
    const bf16* QK = (const bf16*)(a.ws + WS_QK); const bf16* VT = (const bf16*)(a.ws + WS_VT); const bf16* CK = (const bf16*)(a.ws + WS_CK); const bf16* CVT = (const bf16*)(a.ws + WS_CVT);
    const bf16* KH = QK + (size_t)T * 2048;
    bf16* AO = (bf16*)(a.ws + WS_AO);
    const int lane = tid & 63, wave = __builtin_amdgcn_readfirstlane(tid >> 6), ln = lane & 15, kg = lane >> 4;
    unsigned kst = (unsigned)((tid >> 4) * AT_KP * 2 + (tid & 15) * 16), vst = (unsigned)AT_KB + (unsigned)((tid >> 3) * AT_VP * 2 + (tid & 7) * 16);
    unsigned kfo = (unsigned)((8 * (ln >> 2) + (ln & 3)) * AT_KP * 2 + kg * 16), vfo = (unsigned)AT_KB + (unsigned)(ln * AT_VP * 2 + kg * 16);
    asm volatile("" : "+v"(kst), "+v"(vst), "+v"(kfo), "+v"(vfo));
    for (int u = ulo + bid; u < uhi; u += G) {
        int h, tq0;
        const bool lat = u >= 512;
        int b = 0, bs = 0, rp2 = 0;
        if (!lat) { b = u >> 5; h = (u >> 1) & 15; tq0 = b * 256 + (u & 1) * 128 + 16 * wave; }
        else { const int v = u - 512; bs = v >> 7; h = (v >> 3) & 15; rp2 = 2 * (v & 7); tq0 = T_P + bs * 1024 + (rp2 + (wave >> 2)) * 64 + 16 * (wave & 3); }
        const int r = rp2 + (wave >> 2);
        bf16x8 qf[4];
#pragma unroll
        for (int c = 0; c < 4; ++c) qf[c] = *(const bf16x8*)(QK + ((size_t)h * T + tq0 + ln) * 128 + 32 * c + 8 * kg);
        AttState st;
#pragma unroll
        for (int dt = 0; dt < 8; ++dt) st.o[dt] = (f32x4){0.f, 0.f, 0.f, 0.f};
        st.m = -1e30f; st.l = 0.f;
        const int cq = wave & 3, row_start = clampi(r - 4, 0, 8), qcol = 16 * cq + ln, col_start = clampi(qcol - 8, 0, 48);
        const int h0 = cq == 3 ? 1 : 0, h1 = cq == 0 ? 1 : 2;
        const int rs0 = clampi(rp2 - 4, 0, 8), nlat = lat ? clampi(rp2 + 1 - 4, 0, 8) + 8 - rs0 : 0, ntile = nlat + 4;
        const size_t cm = ((size_t)bs * 2 + li) * 16 + h;
        auto src_of = [&](int j) -> AttSrc {
            AttSrc t;
            if (!lat) { const int tb = b * 256 + 64 * j; t.kb = KH + ((size_t)h * T + tb) * 128; t.vb = VT + (size_t)(h * 128) * VTP + tb; t.vstride = VTP; }
            else if (j < nlat) { const int tb = T_P + bs * 1024 + (rs0 + j) * 64; t.kb = KH + ((size_t)h * T + tb) * 128; t.vb = VT + (size_t)(h * 128) * VTP + tb; t.vstride = VTP; }
            else { const int kt = j - nlat; t.kb = CK + (cm * 256 + 64 * kt) * 128; t.vb = CVT + cm * 128 * 256 + 64 * kt; t.vstride = 256; }
            return t;
        };
        u32x4 sk[2], sv[2];
        auto stage_load = [&](int j) { const AttSrc t = src_of(j);
#pragma unroll
            for (int q = 0; q < 2; ++q) { sk[q] = *(const u32x4*)((const char*)t.kb + (size_t)(tid + 512 * q) * 16);
                sv[q] = *(const u32x4*)((const char*)t.vb + ((size_t)((tid >> 3) + 64 * q) * t.vstride) * 2 + (tid & 7) * 16); } };
        auto stage_store = [&](int buf) {
#pragma unroll
            for (int q = 0; q < 2; ++q) { *(LAS u32x4*)(lds + buf * AT_STAGE + kst + q * (32 * AT_KP * 2)) = sk[q]; *(LAS u32x4*)(lds + buf * AT_STAGE + vst + q * (64 * AT_VP * 2)) = sv[q]; } };
        __syncthreads();
        if (lat && tid < 15 * 31) { const int dr = tid / 31, dc = tid - dr * 31; ((LAS float*)(lds + AT_RP))[dr * 32 + dc] = a.in[IN_RPB][((size_t)li * 16 + h) * 15 * 31 + tid]; }
        stage_load(0); stage_store(0);
        __syncthreads();
#pragma unroll 1
        for (int j = 0; j < ntile; ++j) {
            const int buf = j & 1;
            if (j + 1 < ntile) stage_load(j + 1);
            const bool islat = lat && j < nlat; const int krow = rs0 + j;
            const bool act = !islat || (krow >= row_start && krow < row_start + 8);
            if (act) {
                if (!islat) attn_full(st, qf, lds, buf * AT_STAGE + kfo, buf * AT_STAGE + vfo);
                else for (int hf = h0; hf < h1; ++hf)
                    attn_half(st, qf, lds, buf * AT_STAGE + kfo + hf * (32 * AT_KP * 2), buf * AT_STAGE + vfo + hf * 64, kg, 1, krow - r + 7, 32 * hf, qcol, col_start);
            }
            if (j + 1 < ntile) stage_store(buf ^ 1);
            __syncthreads();
        }
        const float inv = 1.f / st.l;
        bf16* op = AO + (size_t)(tq0 + ln) * D + h * 128 + 4 * kg;
#pragma unroll
        for (int dt = 0; dt < 8; ++dt) { const f32x4 o = st.o[dt] * inv; u32x2 w; w.x = cvtpk(o[0], o[1]); w.y = cvtpk(o[2], o[3]); *(u32x2*)(op + 16 * dt) = w; }
    }
}

constexpr int GL_QD = 0, GL_KLT = 33792, GL_P = 70656, GL_DEC = 79872, GL_IMG = 80896, GL_KD = 80896, GL_GT = 114688;
constexpr int GL_QS = 264, GL_KLS = 72, GL_PS = 72;
constexpr size_t WS_GIMG = WS_HID;
#define LDSP(T_, off) ((LAS T_*)(lds + (off)))
__device__ __forceinline__ int gla_img_index(int seq, int nc, int hh, int dir) { const int cb = seq < 16 ? 4 * seq : 64 + 16 * (seq - 16); return ((cb + nc) * 4 + hh) * 2 + dir; }

__device__ __forceinline__ void gla_prep_unit(const Args& a, LAS unsigned char* lds, int tid, int li, int seq, int nc, int hh, int dir) {
    const bf16* QK = (const bf16*)(a.ws + WS_QK); const float* TLR = (const float*)(a.ws + WS_TLR);
    const int lane = tid & 63, wave = __builtin_amdgcn_readfirstlane(tid >> 6), ln = lane & 15, kg = lane >> 4;
    const bool lat = seq >= 16;
    const int tok0 = (lat ? T_P + (seq - 16) * 1024 : seq * 256) + nc * 64;
    const int half = lane >> 5, i0 = 2 * (lane & 31), ca = half * 128 + i0;
    unsigned la_w = (unsigned)(8 * wave * GL_QS + ca) * 2u;
    unsigned la_klt = (unsigned)GL_KLT + (unsigned)(ca * GL_KLS + 8 * wave) * 2u;
    unsigned la_gt = (unsigned)GL_GT + (unsigned)ca * 4u;
    unsigned la_dec = (unsigned)GL_DEC + (unsigned)ca * 4u;
    unsigned la_fr = (unsigned)(ln * GL_QS + 8 * kg) * 2u;
    unsigned la_pw = (unsigned)GL_P + (unsigned)(ln * GL_PS + 4 * kg) * 2u;
    asm volatile("" : "+v"(la_w), "+v"(la_klt), "+v"(la_gt), "+v"(la_dec), "+v"(la_fr), "+v"(la_pw));
    const float* w2p = a.in[IN_WA2] + ((size_t)li * 2 + dir) * 16 * 1024 + hh * 256 + ca;
    const float* bap = a.in[IN_BA] + ((size_t)li * 2 + dir) * 1024 + hh * 256 + ca;
    const float bz0 = bap[0], bz1 = bap[1], bz2 = bap[64], bz3 = bap[65];
    const float fr0 = exp2f(-(float)i0 * (13.287712379549449f / 64.f)), fr1 = exp2f(-(float)(i0 + 1) * (13.287712379549449f / 64.f));
    unsigned qk[8][4];
    { const bf16* qp = QK + (size_t)(tok0 + 8 * wave) * 4096 + hh * 256 + ca;
#pragma unroll
      for (int t = 0; t < 8; ++t, qp += 4096) { qk[t][0] = *(const unsigned*)(qp); qk[t][1] = *(const unsigned*)(qp + 64); qk[t][2] = *(const unsigned*)(qp + 1024); qk[t][3] = *(const unsigned*)(qp + 1024 + 64); } }
    float cum[8][4];
    {
        f32x2 za[8], zb[8];
#pragma unroll
        for (int t = 0; t < 8; ++t) { za[t] = (f32x2){bz0, bz1}; zb[t] = (f32x2){bz2, bz3}; }
        const float* wp = w2p; const float* tp = TLR + (size_t)(tok0 + 8 * wave) * 32 + dir * 16;
#pragma unroll 2
        for (int r4 = 0; r4 < 4; ++r4, tp += 4) {
            f32x2 wa[4], wb[4];
#pragma unroll
            for (int rr = 0; rr < 4; ++rr, wp += 1024) { wa[rr] = *(const f32x2*)wp; wb[rr] = *(const f32x2*)(wp + 64); }
#pragma unroll
            for (int t = 0; t < 8; ++t) { const f32x4 tl = *(const f32x4*)(tp + t * 32);
#pragma unroll
                for (int rr = 0; rr < 4; ++rr) { za[t] += wa[rr] * tl[rr]; zb[t] += wb[rr] * tl[rr]; } }
        }
#pragma unroll
        for (int t = 0; t < 8; ++t) { cum[t][0] = za[t][0]; cum[t][1] = za[t][1]; cum[t][2] = zb[t][0]; cum[t][3] = zb[t][1]; }
        float run[4] = {0.f, 0.f, 0.f, 0.f};
        if (dir == 0) {
#pragma unroll
            for (int t = 0; t < 8; ++t)
#pragma unroll
                for (int e = 0; e < 4; ++e) { run[e] += logsigmoid_f(cum[t][e]) * (1.f / 16.f); cum[t][e] = run[e]; }
        } else {
#pragma unroll
            for (int t = 7; t >= 0; --t)
#pragma unroll
                for (int e = 0; e < 4; ++e) { run[e] += logsigmoid_f(cum[t][e]) * (1.f / 16.f); cum[t][e] = run[e]; }
        }
        *LDSP(f32x2, la_gt + wave * 1024) = (f32x2){run[0], run[1]}; *LDSP(f32x2, la_gt + wave * 1024 + 256) = (f32x2){run[2], run[3]};
    }
    __syncthreads();
    {
        float pre[4] = {0.f, 0.f, 0.f, 0.f}, tot[4] = {0.f, 0.f, 0.f, 0.f};
#pragma unroll
        for (int g = 0; g < 8; ++g) { const f32x2 x = *LDSP(f32x2, la_gt + g * 1024), y = *LDSP(f32x2, la_gt + g * 1024 + 256);
            const bool before = dir ? (g > wave) : (g < wave);
            tot[0] += x[0]; tot[1] += x[1]; tot[2] += y[0]; tot[3] += y[1];
            if (before) { pre[0] += x[0]; pre[1] += x[1]; pre[2] += y[0]; pre[3] += y[1]; } }
        float dtot[4];
#pragma unroll
        for (int e = 0; e < 4; ++e) dtot[e] = __expf(tot[e]);
        if (wave == 0) { *LDSP(f32x2, la_dec) = (f32x2){dtot[0], dtot[1]}; *LDSP(f32x2, la_dec + 256) = (f32x2){dtot[2], dtot[3]}; }
        unsigned klp[4][4];
        float klh[4] = {0.f, 0.f, 0.f, 0.f};
#pragma unroll
        for (int t = 0; t < 8; ++t) {
            const unsigned qa = qk[t][0], qb = qk[t][1], ka = qk[t][2], kb2 = qk[t][3];
            float q[4] = {bflo(qa), bfhi(qa), bflo(qb), bfhi(qb)}, k[4] = {bflo(ka), bfhi(ka), bflo(kb2), bfhi(kb2)};
            if (lat) {
                const float pos = (float)(half ? 8 * wave + t : nc);
                float r0 = pos * fr0 * 0.15915494309189535f, r1 = pos * fr1 * 0.15915494309189535f; r0 -= floorf(r0); r1 -= floorf(r1);
                const float s0 = __builtin_amdgcn_sinf(r0), c0 = __builtin_amdgcn_cosf(r0), s1 = __builtin_amdgcn_sinf(r1), c1 = __builtin_amdgcn_cosf(r1);
                const float q0 = q[0] * c0 - q[2] * s0, q2 = q[0] * s0 + q[2] * c0, q1 = q[1] * c1 - q[3] * s1, q3 = q[1] * s1 + q[3] * c1;
                const float k0 = k[0] * c0 - k[2] * s0, k2 = k[0] * s0 + k[2] * c0, k1 = k[1] * c1 - k[3] * s1, k3 = k[1] * s1 + k[3] * c1;
                q[0] = q0; q[1] = q1; q[2] = q2; q[3] = q3; k[0] = k0; k[1] = k1; k[2] = k2; k[3] = k3;
            }
            float qd[4], kd[4];
#pragma unroll
            for (int e = 0; e < 4; ++e) { const float cm = pre[e] + cum[t][e], ec = __expf(cm), ei = __builtin_amdgcn_rcpf(ec); qd[e] = q[e] * 0.0625f * ec; kd[e] = k[e] * ei;
                const float kl = kd[e] * dtot[e]; if (t & 1) klp[e][t >> 1] = cvtpk(klh[e], kl); else klh[e] = kl; }
            *LDSP(unsigned, GL_QD + la_w + t * (GL_QS * 2)) = cvtpk(qd[0], qd[1]); *LDSP(unsigned, GL_QD + la_w + t * (GL_QS * 2) + 128) = cvtpk(qd[2], qd[3]);
            *LDSP(unsigned, GL_KD + la_w + t * (GL_QS * 2)) = cvtpk(kd[0], kd[1]); *LDSP(unsigned, GL_KD + la_w + t * (GL_QS * 2) + 128) = cvtpk(kd[2], kd[3]);
        }
#pragma unroll
        for (int e = 0; e < 4; ++e) { const int coff = ((e < 2 ? 0 : 64) + (e & 1)) * GL_KLS * 2;
            u32x4 w; w.x = klp[e][0]; w.y = klp[e][1]; w.z = klp[e][2]; w.w = klp[e][3];
            *LDSP(u32x4, la_klt + coff) = w; }
    }
    __syncthreads();
#pragma unroll
    for (int j = 0; j < 2; ++j) { const int idx = 2 * wave + j, sb = idx >> 2, tbk = idx & 3;
        f32x4 acc = {0.f, 0.f, 0.f, 0.f};
        const unsigned ka_ = GL_KD + la_fr + sb * (16 * GL_QS * 2), qa_ = GL_QD + la_fr + tbk * (16 * GL_QS * 2);
#pragma unroll
        for (int c = 0; c < 8; ++c) { const bf16x8 af = *LDSP(const bf16x8, ka_ + 64 * c), bfr = *LDSP(const bf16x8, qa_ + 64 * c); acc = MFMA16(af, bfr, acc); }
        const int t = 16 * tbk + ln;
        float pv[4];
#pragma unroll
        for (int i = 0; i < 4; ++i) { const int s = 16 * sb + 4 * kg + i; const bool keep = dir ? (s >= t) : (s <= t); pv[i] = keep ? acc[i] : 0.f; }
        u32x2 w; w.x = cvtpk(pv[0], pv[1]); w.y = cvtpk(pv[2], pv[3]);
        *LDSP(u32x2, la_pw + tbk * (16 * GL_PS * 2) + sb * 32) = w; }
    __syncthreads();
    {
        unsigned char* img = a.ws + WS_GIMG + (size_t)gla_img_index(seq, nc, hh, dir) * GL_IMG;
#pragma unroll
        for (int j = 0; j < 10; ++j) { const int pc = tid + 512 * j; if (pc < GL_IMG / 16) *(u32x4*)(img + (size_t)pc * 16) = *LDSP(const u32x4, pc * 16); }
    }
    __syncthreads();
}

__device__ __forceinline__ void gla_prep_phase(const Args& a, LAS unsigned char* lds, int bid, int G, int tid, int li) {
    for (int u = bid; u < 768; u += G) { const int dir = u & 1, hh = (u >> 1) & 3, cpos = u >> 3;
        const int seq = cpos < 64 ? cpos >> 2 : 16 + ((cpos - 64) >> 4), nc = cpos < 64 ? cpos & 3 : (cpos - 64) & 15;
        gla_prep_unit(a, lds, tid, li, seq, nc, hh, dir); }
}

__device__ __forceinline__ void gla_scan_unit(const Args& a, LAS unsigned char* lds, int tid, int li, int seq, int hh, int dir, int dvs) {
    const bf16* VT = (const bf16*)(a.ws + WS_VT); float* OG = (float*)(a.ws + WS_OG);
    const int lane = tid & 63, wave = __builtin_amdgcn_readfirstlane(tid >> 6), ln = lane & 15, kg = lane >> 4;
    const bool lat = seq >= 16;
    const int tb = lat ? T_P + (seq - 16) * 1024 : seq * 256, nch = lat ? 16 : 4;
    unsigned la_fr = (unsigned)GL_QD + (unsigned)(ln * GL_QS + 8 * kg) * 2u;
    unsigned la_p = (unsigned)GL_P + (unsigned)(ln * GL_PS + 8 * kg) * 2u;
    unsigned la_kr = (unsigned)GL_KLT + (unsigned)((8 * (ln >> 2) + (ln & 3)) * GL_KLS + 8 * kg) * 2u;
    unsigned la_dr = (unsigned)GL_DEC + (unsigned)(8 * kg) * 4u;
    unsigned la_cp = (unsigned)tid * 16u;
    asm volatile("" : "+v"(la_fr), "+v"(la_p), "+v"(la_kr), "+v"(la_dr), "+v"(la_cp));
    const int dvcol = dvs * 128 + 16 * wave + ln;
    f32x4 Sacc[8][2];
    if (lat) { const float* sp = a.in[IN_SG] + ((((size_t)(seq - 16) * 2 + li) * 2 + dir) * 4 + hh) * 256 * 512 + dvcol + (size_t)(8 * kg) * 512;
#pragma unroll
        for (int c = 0; c < 8; ++c)
#pragma unroll
            for (int s = 0; s < 2; ++s)
#pragma unroll
                for (int i = 0; i < 4; ++i) Sacc[c][s][i] = sp[(size_t)(32 * c + 4 * s + i) * 512];
    } else {
#pragma unroll
        for (int c = 0; c < 8; ++c)
#pragma unroll
            for (int s = 0; s < 2; ++s) Sacc[c][s] = (f32x4){0.f, 0.f, 0.f, 0.f};
    }
    const bf16* vrow = VT + (size_t)(hh * 512 + dvcol) * VTP + 8 * kg;
    const unsigned char* imgs = a.ws + WS_GIMG;
    u32x4 stg[10]; bf16x8 vfn[2];
    { const int nc = dir ? nch - 1 : 0; const unsigned char* img = imgs + (size_t)gla_img_index(seq, nc, hh, dir) * GL_IMG + la_cp;
#pragma unroll
      for (int j = 0; j < 10; ++j) if (j < 9 || tid < (GL_IMG / 16 - 9 * 512)) stg[j] = *(const u32x4*)(img + (size_t)j * 8192);
#pragma unroll
      for (int c = 0; c < 2; ++c) vfn[c] = *(const bf16x8*)(vrow + tb + nc * 64 + 32 * c); }
#pragma unroll 1
    for (int p = 0; p < nch; ++p) {
        const int nc = dir ? nch - 1 - p : p, tok0 = tb + nc * 64;
#pragma unroll
        for (int j = 0; j < 10; ++j) if (j < 9 || tid < (GL_IMG / 16 - 9 * 512)) *LDSP(u32x4, la_cp + j * 8192) = stg[j];
        bf16x8 vf[2] = {vfn[0], vfn[1]};
        __syncthreads();
        if (p + 1 < nch) { const int nn = dir ? nch - 2 - p : p + 1; const unsigned char* img = imgs + (size_t)gla_img_index(seq, nn, hh, dir) * GL_IMG + la_cp;
#pragma unroll
            for (int j = 0; j < 10; ++j) if (j < 9 || tid < (GL_IMG / 16 - 9 * 512)) stg[j] = *(const u32x4*)(img + (size_t)j * 8192);
#pragma unroll
            for (int c = 0; c < 2; ++c) vfn[c] = *(const bf16x8*)(vrow + tb + nn * 64 + 32 * c); }
        {
            bf16x8 sf[8];
#pragma unroll
            for (int c = 0; c < 8; ++c) { u32x4 w; w.x = cvtpk(Sacc[c][0][0], Sacc[c][0][1]); w.y = cvtpk(Sacc[c][0][2], Sacc[c][0][3]); w.z = cvtpk(Sacc[c][1][0], Sacc[c][1][1]); w.w = cvtpk(Sacc[c][1][2], Sacc[c][1][3]);
                sf[c] = __builtin_bit_cast(bf16x8, w); }
            const size_t ogi = (size_t)dir * T * D + (size_t)(tok0 + ln) * D + hh * 512 + dvs * 128 + 16 * wave + 4 * kg;
#pragma unroll
            for (int tt = 0; tt < 4; ++tt) {
                f32x4 o = {0.f, 0.f, 0.f, 0.f};
#pragma unroll
                for (int c = 0; c < 2; ++c) { const bf16x8 pf = *LDSP(const bf16x8, la_p + tt * (16 * GL_PS * 2) + 64 * c); o = MFMA16(vf[c], pf, o); }
#pragma unroll
                for (int c = 0; c < 8; ++c) { const bf16x8 qf = *LDSP(const bf16x8, la_fr + tt * (16 * GL_QS * 2) + 64 * c); o = MFMA16(sf[c], qf, o); }
                if (OG_BF16) { u32x2 w; w.x = cvtpk(o[0], o[1]); w.y = cvtpk(o[2], o[3]); *(u32x2*)((bf16*)OG + ogi + (size_t)(16 * tt) * D) = w; }
                else *(f32x4*)(OG + ogi + (size_t)(16 * tt) * D) = o;
            }
#pragma unroll
            for (int c = 0; c < 8; ++c)
#pragma unroll
                for (int s = 0; s < 2; ++s) {
                    const f32x4 dc = *LDSP(const f32x4, la_dr + (32 * c + 4 * s) * 4);
                    f32x4 acc = Sacc[c][s] * dc;
#pragma unroll
                    for (int c2 = 0; c2 < 2; ++c2) { const bf16x8 kf = *LDSP(const bf16x8, la_kr + (32 * c + 4 * s) * (GL_KLS * 2) + 64 * c2); acc = MFMA16(kf, vf[c2], acc); }
                    Sacc[c][s] = acc;
                }
        }
        __syncthreads();
    }
    if (!lat) { float* sp = a.out + OUT_GLA + ((((size_t)seq * 2 + li) * 2 + dir) * 4 + hh) * 256 * 512 + dvcol + (size_t)(8 * kg) * 512;
#pragma unroll
        for (int c = 0; c < 8; ++c)
#pragma unroll
            for (int s = 0; s < 2; ++s)
#pragma unroll
                for (int i = 0; i < 4; ++i) sp[(size_t)(32 * c + 4 * s + i) * 512] = Sacc[c][s][i];
    }
}

__device__ __forceinline__ void gla_scan_phase(const Args& a, LAS unsigned char* lds, int bid, int G, int tid, int li) {
    if (G > 64) {
        if (bid < 64) { const int u = bid; gla_scan_unit(a, lds, tid, li, 16 + (u >> 5), (u >> 3) & 3, (u >> 2) & 1, u & 3); }
        else for (int u = bid - 64; u < 512; u += G - 64) gla_scan_unit(a, lds, tid, li, u >> 5, (u >> 3) & 3, (u >> 2) & 1, u & 3);
    } else {
        for (int u = bid; u < 576; u += G) gla_scan_unit(a, lds, tid, li, u >> 5, (u >> 3) & 3, (u >> 2) & 1, u & 3);
    }
}
#undef LDSP

#ifndef PROBE_DOUBLE
#define PROBE_DOUBLE 0
#endif
#ifndef STAGGER
#define STAGGER 0
#endif
#ifndef W2_SPLITK
#define W2_SPLITK 0
#endif
constexpr int LDS_BYTES = 147456;
constexpr int MISC_OFF = 131072 + 320;

__global__ void __launch_bounds__(512, 2) mega_fwd(Args a) {
    extern __shared__ __attribute__((aligned(16))) unsigned char lds_raw[];
    LAS unsigned char* lds = (LAS unsigned char*)lds_raw;
    volatile LAS unsigned* MISC = (volatile LAS unsigned*)(lds + MISC_OFF);
    const int G = gridDim.x, bid = blockIdx.x;
    for (int u = threadIdx.x; u < (LDS_BYTES - 131072) / 4; u += 512) ((LAS unsigned*)(lds + 131072))[u] = 0u;
    __syncthreads();
    unsigned* ctl = (unsigned*)(a.ws + WS_CTL);
    const int lo = a.ph_lo, hi = a.ph_hi;
    XcdBarrier bar = xcd_barrier_post(ctl + CW_BAR + lo * XCD_BAR_WORDS, MISC + 8);
#define IN(k) (lo <= (k) && (k) < hi)
#define SEAM(k) do { if (IN(k) && IN((k) + 1)) { xcd_barrier(bar); if (PROBE_DOUBLE & 16) xcd_barrier(bar); } } while (0)
    const int ngw = G * 8;
#define LANEVARS int tid = threadIdx.x; asm volatile("" : "+v"(tid)); const int lane = tid & 63, wave = __builtin_amdgcn_readfirstlane(tid >> 6), gw = bid * 8 + wave; (void)lane; (void)gw
    unsigned char* ws = a.ws;
    const float* MOD = (const float*)(ws + WS_MOD);
    const float* NG = a.in[IN_NORMG];
    bf16* H = (bf16*)(ws + WS_H); bf16* QK = (bf16*)(ws + WS_QK); bf16* VT = (bf16*)(ws + WS_VT); bf16* AO = (bf16*)(ws + WS_AO); bf16* HID = (bf16*)(ws + WS_HID);
    float* Y = (float*)(ws + WS_Y); float* TLR = (float*)(ws + WS_TLR);

    if (IN(PH_PRO)) { LANEVARS; prologue_phase(a, lds, bid, G, tid); if (PROBE_DOUBLE & 8) { __syncthreads(); prologue_phase(a, lds, bid, G, tid); } }
    SEAM(PH_PRO);
    if (IN(PH_R0)) { LANEVARS; row_phase<true, false, true>(a, gw, ngw, lane, nullptr, nullptr, 0, NG + 0 * D, MOD, 0, 1); }
    SEAM(PH_R0);

    for (int l = 0; l < NL; ++l) {
        const int pb = PH_L0 + l * PH_PER_LAYER, li = l >> 1;
        const bool gla = l & 1;
        const bf16* Wmix = (const bf16*)(ws + WS_WMIX) + (size_t)l * NMIX * D;
        const float* MODl = MOD + (size_t)l * 3 * 12288;
        for (int rep = 0; rep < ((PROBE_DOUBLE & (1 | 2048)) ? 2 : 1); ++rep)
        if (IN(pb + LP_MIX)) {
            if (!gla) {
                { pg8::Gemm g{H, Wmix, T, NQK_NA, D}; pg8::StaticOrder S; S.init(T, NQK_NA, G, bid);
                  EpiWrap<E8NaQK> E{{QK, a.out + OUT_NK, li}}; pg8::gemm_phase<EpiWrap<E8NaQK>, pg8::StaticOrder, false, true>(lds, g, S, E); }
                { pg8::Gemm g{Wmix + (size_t)NQK_NA * D, H, 2048, T, D}; pg8::StaticOrder S; S.init(2048, T, G, (bid + 128) % G);
                  EpiWrap<E8VT> E{{VT, a.out + OUT_NV, li}}; pg8::gemm_phase<EpiWrap<E8VT>, pg8::StaticOrder, false, true>(lds, g, S, E); }
            } else {
                { pg8::Gemm g{H, Wmix, T, NQK_GLA, D}; pg8::StaticOrder S; S.init(T, NQK_GLA, G, bid);
                  EpiWrap<E8GlaQKG> E{{QK, TLR}}; pg8::gemm_phase<EpiWrap<E8GlaQKG>, pg8::StaticOrder, false, true>(lds, g, S, E); }
                { pg8::Gemm g{Wmix + (size_t)NQK_GLA * D, H, 2048, T, D}; pg8::StaticOrder S; S.init(2048, T, G, (bid + 104) % G);
                  EpiWrap<E8VT> E{{VT, nullptr, 0}}; pg8::gemm_phase<EpiWrap<E8VT>, pg8::StaticOrder, false, true>(lds, g, S, E); }
            }
        }
        if (IN(pb + LP_MIX) && l + 1 < NL) {
            const int first = gla ? 88 : 64;
            if (G == 256 && bid >= first) { LANEVARS; if (ADA_DEFER) { __syncthreads(); silu_table(a, lds, tid); ada_layer(a, lds, l + 1, bid - first, G - first, tid); } convert_weights(a, lds, l + 1, 0, CV_MIX_END, bid - first, G - first, tid); }
        }
        SEAM(pb + LP_MIX);
        if (IN(pb + LP_CORE)) {
            LANEVARS; if (!gla) { attn_phase(a, lds, bid, G, tid, li); if (PROBE_DOUBLE & 2) attn_phase(a, lds, bid, G, tid, li); if (PROBE_DOUBLE & 64) attn_phase(a, lds, bid, G, tid, li, 0, 512); if (PROBE_DOUBLE & 128) attn_phase(a, lds, bid, G, tid, li, 512, 768); }
            else { gla_prep_phase(a, lds, bid, G, tid, li); if (PROBE_DOUBLE & 32) gla_prep_phase(a, lds, bid, G, tid, li);
                   xcd_barrier(bar);
                   gla_scan_phase(a, lds, bid, G, tid, li); if (PROBE_DOUBLE & 4) gla_scan_phase(a, lds, bid, G, tid, li); }
        }
        SEAM(pb + LP_CORE);
        if (gla) {
            if (IN(pb + LP_GATE)) { LANEVARS; gla_gate_phase(a, gw, ngw, lane, li); }
            SEAM(pb + LP_GATE);
        }
        for (int rep = 0; rep < ((PROBE_DOUBLE & (1 | 1024)) ? 2 : 1); ++rep)
        if (IN(pb + LP_WO)) {
            if (l + 1 < NL && G == 256 && bid >= 192) { LANEVARS; convert_weights(a, lds, l + 1, CV_MIX_END, CV_WO_END, bid - 192, G - 192, tid); }
            pg8::Gemm g{AO, (const bf16*)(ws + WS_WO) + (size_t)l * D * D, T, D, D}; pg8::StaticOrder S; S.init(T, D, G, bid);
            if (Y_BF16) { EpiWrap<E8Bf16> E{{(bf16*)Y, D}}; pg8::gemm_phase<EpiWrap<E8Bf16>, pg8::StaticOrder, false, true>(lds, g, S, E); }
            else { EpiWrap<E8F32> E{{Y, D}}; pg8::gemm_phase<EpiWrap<E8F32>, pg8::StaticOrder, false, true>(lds, g, S, E); }
        }
        SEAM(pb + LP_WO);
        if (IN(pb + LP_ROWMID)) { LANEVARS; row_phase<false, true, true>(a, gw, ngw, lane, NG + ((size_t)l * 4 + 1) * D, MODl, 2, NG + ((size_t)l * 4 + 2) * D, MODl, 3, 4); }
        SEAM(pb + LP_ROWMID);
        for (int rep = 0; rep < ((PROBE_DOUBLE & (1 | 256)) ? 2 : 1); ++rep)
        if (IN(pb + LP_W1)) {
            if (STAGGER) { const int pos = (bid >> 3) & 31; for (int i = 0; i < pos; ++i) __builtin_amdgcn_s_sleep(STAGGER); }
            pg8::Gemm g{H, (const bf16*)(ws + WS_W1) + (size_t)l * FF * D, T, FF, D}; pg8::StaticOrder S; S.init(T, FF, G, bid);
            EpiWrap<E8Relu2> E{{HID, FF}}; pg8::gemm_phase<EpiWrap<E8Relu2>, pg8::StaticOrder, false, true>(lds, g, S, E);
        }
        SEAM(pb + LP_W1);
        for (int rep = 0; rep < ((PROBE_DOUBLE & (1 | 512)) ? 2 : 1); ++rep)
        if (IN(pb + LP_W2)) {
            constexpr int W2_UNITS = (T / 256) * (D / 256);
            if (!W2_SPLITK && l + 1 < NL && G == 256 && bid >= W2_UNITS) { LANEVARS; convert_weights(a, lds, l + 1, CV_WO_END, CV_W2_END, bid - W2_UNITS, G - W2_UNITS, tid); }

            pg8::Gemm g{HID, (const bf16*)(ws + WS_W2) + (size_t)l * D * FF, T, D, FF};
            EpiF32Part E{Y, Y + (size_t)T * D};
            if (G == 256 && W2_SPLITK) { SplitKOrder S{bid}; pg8::gemm_phase<EpiF32Part, SplitKOrder, true, true>(lds, g, S, E); }
            else if (Y_BF16) { pg8::StaticOrder S; S.init(T, D, G, bid); EpiWrap<E8Bf16> E2{{(bf16*)Y, D}}; pg8::gemm_phase<EpiWrap<E8Bf16>, pg8::StaticOrder, false, true>(lds, g, S, E2); }
            else { pg8::StaticOrder S; S.init(T, D, G, bid); pg8::gemm_phase<EpiF32Part, pg8::StaticOrder, false, true>(lds, g, S, E); }
        }
        SEAM(pb + LP_W2);
        if (IN(pb + LP_ROWEND)) {
            LANEVARS;
            if (G == 256 && W2_SPLITK) {
                if (l < NL - 1) row_phase<false, true, true, true>(a, gw, ngw, lane, NG + ((size_t)l * 4 + 3) * D, MODl, 5, NG + ((size_t)(l + 1) * 4 + 0) * D, MODl + 3 * 12288, 0, 1);
                else            row_phase<false, true, false, true>(a, gw, ngw, lane, NG + ((size_t)l * 4 + 3) * D, MODl, 5, nullptr, nullptr, 0, 0);
            } else {
                if (l < NL - 1) row_phase<false, true, true>(a, gw, ngw, lane, NG + ((size_t)l * 4 + 3) * D, MODl, 5, NG + ((size_t)(l + 1) * 4 + 0) * D, MODl + 3 * 12288, 0, 1);
                else            row_phase<false, true, false>(a, gw, ngw, lane, NG + ((size_t)l * 4 + 3) * D, MODl, 5, nullptr, nullptr, 0, 0);
            }
        }
        SEAM(pb + LP_ROWEND);
    }
#undef IN
#undef SEAM
#undef LANEVARS
}

static void launch_range(const Args& base, int lo, int hi, int grid, hipStream_t stream) {
    if (lo >= hi) return;
    Args a = base; a.ph_lo = lo; a.ph_hi = hi;
    hipLaunchKernelGGL(mega_fwd, dim3(grid), dim3(512), LDS_BYTES, stream, a);
    const hipError_t le = hipPeekAtLastError();
    if (le != hipSuccess) fprintf(stderr, "kernel_launch: mega_fwd [%d,%d) failed: %s\n", lo, hi, hipGetErrorName(le));
}
template <class E8> static void launch_ref_gemm(const bf16* A, const bf16* Bt, int M, int N, int K, const E8& E, hipStream_t stream) {
    hipLaunchKernelGGL((ref_gemm<E8>), dim3(N / 64, M / 64), dim3(256), 0, stream, A, Bt, M, N, K, E);
}

extern "C" void kernel_launch(void* const* d_in, const int* in_sizes, int n_in, void* d_out, int out_size, void* d_ws, size_t ws_size, hipStream_t stream) {
    static int grid = 0;
    if (grid == 0) {
        if (n_in != 21 || (size_t)out_size != OUT_TOTAL || ws_size < WS_END) { fprintf(stderr, "kernel_launch: unexpected shapes (n_in %d out %d ws %zu)\n", n_in, out_size, ws_size); grid = -1; return; }
        int dev = 0, cus = 0, per_cu = 0;
        if (hipGetDevice(&dev) != hipSuccess || hipDeviceGetAttribute(&cus, hipDeviceAttributeMultiprocessorCount, dev) != hipSuccess) { grid = -1; return; }
        if (hipFuncSetAttribute((const void*)mega_fwd, hipFuncAttributeMaxDynamicSharedMemorySize, LDS_BYTES) != hipSuccess) { fprintf(stderr, "kernel_launch: hipFuncSetAttribute failed\n"); grid = -1; return; }
        if (hipOccupancyMaxActiveBlocksPerMultiprocessor(&per_cu, (const void*)mega_fwd, 512, LDS_BYTES) != hipSuccess || per_cu < 1) fprintf(stderr, "kernel_launch: occupancy query says %d\n", per_cu);
        (void)hipGetLastError();
        grid = cus;
    }
    if (grid < 0) return;
    (void)hipMemsetAsync((char*)d_ws + WS_CTL, 0, CTL_ZERO_BYTES, stream);
    Args a{};
    for (int i = 0; i < 21; ++i) a.in[i] = (const float*)d_in[i];
    a.out = (float*)d_out; a.ws = (unsigned char*)d_ws;
#if CFG_ONE_LAUNCH && !CFG_NAIVE_GEMM && !CFG_NAIVE_ATTN && !CFG_NAIVE_GLA
    launch_range(a, 0, NPH, grid, stream);
#else
    unsigned char* ws = (unsigned char*)d_ws;
    bf16* H = (bf16*)(ws + WS_H); bf16* QK = (bf16*)(ws + WS_QK); bf16* VT = (bf16*)(ws + WS_VT); bf16* AO = (bf16*)(ws + WS_AO); bf16* HID = (bf16*)(ws + WS_HID);
    float* Y = (float*)(ws + WS_Y); float* TLR = (float*)(ws + WS_TLR);
    launch_range(a, PH_PRO, PH_PRO + 1, grid, stream);
    launch_range(a, PH_R0, PH_R0 + 1, grid, stream);
    for (int l = 0; l < NL; ++l) {
        const int pb = PH_L0 + l * PH_PER_LAYER, li = l >> 1; const bool gla = l & 1;
        const bf16* Wmix = (const bf16*)(ws + WS_WMIX) + (size_t)l * NMIX * D;
        if (CFG_NAIVE_GEMM) {
            if (!gla) { launch_ref_gemm(H, Wmix, T, NQK_NA, D, E8NaQK{QK, a.out + OUT_NK, li}, stream); launch_ref_gemm(Wmix + (size_t)NQK_NA * D, H, 2048, T, D, E8VT{VT, a.out + OUT_NV, li}, stream); }
            else { launch_ref_gemm(H, Wmix, T, NQK_GLA, D, E8GlaQKG{QK, TLR}, stream); launch_ref_gemm(Wmix + (size_t)NQK_GLA * D, H, 2048, T, D, E8VT{VT, nullptr, 0}, stream); }
        } else launch_range(a, pb + LP_MIX, pb + LP_MIX + 1, grid, stream);
        if (!gla) { if (CFG_NAIVE_ATTN) hipLaunchKernelGGL(ref_attn, dim3(T * 16), dim3(128), 0, stream, a, li); else launch_range(a, pb + LP_CORE, pb + LP_CORE + 1, grid, stream); }
        else { if (CFG_NAIVE_GLA) hipLaunchKernelGGL(ref_gla, dim3(18 * 4 * 2 * 64), dim3(256), 0, stream, a, li); else launch_range(a, pb + LP_CORE, pb + LP_CORE + 1, grid, stream);
               launch_range(a, pb + LP_GATE, pb + LP_GATE + 1, grid, stream); }
        if (CFG_NAIVE_GEMM) launch_ref_gemm(AO, (const bf16*)(ws + WS_WO) + (size_t)l * D * D, T, D, D, E8F32{Y, D}, stream); else launch_range(a, pb + LP_WO, pb + LP_WO + 1, grid, stream);
        launch_range(a, pb + LP_ROWMID, pb + LP_ROWMID + 1, grid, stream);
        if (CFG_NAIVE_GEMM) launch_ref_gemm(H, (const bf16*)(ws + WS_W1) + (size_t)l * FF * D, T, FF, D, E8Relu2{HID, FF}, stream); else launch_range(a, pb + LP_W1, pb + LP_W1 + 1, grid, stream);
        if (CFG_NAIVE_GEMM) launch_ref_gemm(HID, (const bf16*)(ws + WS_W2) + (size_t)l * D * FF, T, D, FF, E8F32{Y, D}, stream); else launch_range(a, pb + LP_W2, pb + LP_W2 + 1, grid, stream);
        launch_range(a, pb + LP_ROWEND, pb + LP_ROWEND + 1, grid, stream);
    }
#endif
}
```
